# Optimizing an MI355X kernel written in HIP

```python
import math
import jax, jax.numpy as jnp
from jax import lax
import numpy as np

D_MODEL = 1024
BATCH = 8
SEQ = 2048
DEPTH = 2

DIFF_HEADS = 4
DIFF_DH = 64
DIFF_DV = 2 * DIFF_DH
DIFF_QK = DIFF_HEADS * 2 * DIFF_DH
DIFF_WIDTH = DIFF_HEADS * DIFF_DV
ROPE_THETA = 500000.0
ROPE_DIMS = DIFF_DH // 4
Q_BLOCK = 128
CONV_CH = D_MODEL - DIFF_WIDTH
CONV_WIDTH = 3
RET_HEADS = 4
RET_DK = D_MODEL // RET_HEADS
RET_DV = 2 * RET_DK
RET_QK = RET_HEADS * RET_DK
RET_VW = RET_HEADS * RET_DV
RET_CHUNK = 128
RET_ROPE_THETA = 10000.0
D_FF = ((8 * D_MODEL // 3 + 127) // 128) * 128

EVEN_IN = 2 * DIFF_QK + DIFF_WIDTH + 3 * CONV_CH
ODD_IN = 2 * RET_QK + 2 * RET_VW
N_EVEN = (DEPTH + 1) // 2
N_ODD = DEPTH // 2
DEEPNORM_ALPHA = (2.0 * DEPTH) ** 0.25
DEEPNORM_BETA = (8.0 * DEPTH) ** -0.25
LN_EPS = 1e-5
NEG_INF = -1e30

kernel_name = "hybrid_diffattn_shortconv_retention_macaron"


def layer_norm(x, g, b):
    xf = x.astype(jnp.float32)
    mu = jnp.mean(xf, -1, keepdims=True)
    var = jnp.mean(jnp.square(xf - mu), -1, keepdims=True)
    return ((xf - mu) * lax.rsqrt(var + LN_EPS)).astype(x.dtype) * g + b


def rms_norm(x, g):
    xf = x.astype(jnp.float32)
    y = xf * lax.rsqrt(jnp.mean(jnp.square(xf), -1, keepdims=True) + LN_EPS)
    return y.astype(x.dtype) * g


def rotary(x, n_rot, theta):
    s = x.shape[1]
    half = n_rot // 2
    inv = jnp.exp(-math.log(theta) * jnp.arange(half, dtype=jnp.float32) * (2.0 / n_rot))
    ang = jnp.arange(s, dtype=jnp.float32)[:, None] * inv[None, :]
    cos = jnp.cos(ang)[None, :, None, :].astype(x.dtype)
    sin = jnp.sin(ang)[None, :, None, :].astype(x.dtype)
    x1, x2, xp = x[..., :half], x[..., half:n_rot], x[..., n_rot:]
    return jnp.concatenate([x1 * cos - x2 * sin, x2 * cos + x1 * sin, xp], -1)


def swiglu_ffn(x, w_in, w_out):
    gate, up = jnp.split(x @ w_in, 2, axis=-1)
    return (jax.nn.silu(gate) * up) @ w_out


def diff_attention(q, k, v, lam):
    b, s, h2, d = q.shape
    h = h2 // 2
    nblk = s // Q_BLOCK
    scale = d ** -0.5
    qb = q.reshape(b, nblk, Q_BLOCK, h2, d).transpose(1, 0, 3, 2, 4)
    kt = k.transpose(0, 2, 1, 3)
    vt = v.transpose(0, 2, 1, 3)
    kpos = jnp.arange(s)
    starts = jnp.arange(nblk) * Q_BLOCK

    def one_block(args):
        qblk, start = args
        sc = jnp.einsum('bhqd,bhkd->bhqk', qblk, kt).astype(jnp.float32) * scale
        qpos = start + jnp.arange(Q_BLOCK)
        sc = jnp.where(kpos[None, :] <= qpos[:, None], sc, NEG_INF)
        p = jax.nn.softmax(sc, axis=-1).reshape(b, h, 2, Q_BLOCK, s)
        a = p[:, :, 0] - lam * p[:, :, 1]
        return jnp.einsum('bhqk,bhkv->bhqv', a.astype(vt.dtype), vt)

    out = lax.map(one_block, (qb, starts))
    return out.transpose(1, 0, 3, 2, 4).reshape(b, s, h, v.shape[-1])


def short_gated_conv(gate_b, gate_c, hx, w):
    u = gate_c * hx
    y = lax.conv_general_dilated(
        u, w[:, None, :].astype(u.dtype), window_strides=(1,),
        padding=[(CONV_WIDTH - 1, 0)], dimension_numbers=('NWC', 'WIO', 'NWC'),
        feature_group_count=u.shape[-1])
    return gate_b * y


def even_mixer(x, w_in, w_out, lam_vecs, norm_g, conv_w, layer_idx):
    b, s, _ = x.shape
    hcat = x @ w_in
    o1 = DIFF_QK
    o2 = 2 * DIFF_QK
    o3 = o2 + DIFF_WIDTH
    o4 = o3 + CONV_CH
    o5 = o4 + CONV_CH
    q, k, v, cb, cc, cx = jnp.split(hcat, [o1, o2, o3, o4, o5], axis=-1)
    q = rotary(q.reshape(b, s, 2 * DIFF_HEADS, DIFF_DH), ROPE_DIMS, ROPE_THETA)
    k = rotary(k.reshape(b, s, 2 * DIFF_HEADS, DIFF_DH), ROPE_DIMS, ROPE_THETA)
    v = v.reshape(b, s, DIFF_HEADS, DIFF_DV)
    lambda_init = 0.8 - 0.6 * math.exp(-0.3 * layer_idx)
    lv = lam_vecs.astype(jnp.float32)
    lam = jnp.exp(jnp.sum(lv[0] * lv[1])) - jnp.exp(jnp.sum(lv[2] * lv[3])) + lambda_init
    attn = diff_attention(q, k, v, lam)
    attn = (rms_norm(attn, norm_g) * (1.0 - lambda_init)).reshape(b, s, DIFF_WIDTH)
    conv = short_gated_conv(cb, cc, cx, conv_w)
    return jnp.concatenate([attn, conv], axis=-1) @ w_out


def retention(q, k, v):
    b, s, h, dk = q.shape
    dv = v.shape[-1]
    n = s // RET_CHUNK
    log_g = jnp.log1p(-jnp.exp2(-5.0 - jnp.arange(h, dtype=jnp.float32)))
    idx = jnp.arange(RET_CHUNK, dtype=jnp.float32)
    rel = idx[:, None] - idx[None, :]
    intra_decay = jnp.where(rel >= 0, jnp.exp(log_g[:, None, None] * jnp.maximum(rel, 0.0)), 0.0)
    q_decay = jnp.exp(log_g[:, None] * (idx + 1.0))[None, :, :, None]
    k_decay = jnp.exp(log_g[:, None] * (RET_CHUNK - 1.0 - idx))[None, :, :, None]
    chunk_decay = jnp.exp(log_g * RET_CHUNK)[None, :, None, None]

    def to_chunks(t):
        return t.reshape(b, n, RET_CHUNK, h, t.shape[-1]).transpose(1, 0, 3, 2, 4)

    def step(state, inp):
        qc, kc, vc = inp
        sc = jnp.einsum('bhqd,bhkd->bhqk', qc, kc) * intra_decay[None]
        intra = jnp.einsum('bhqk,bhkv->bhqv', sc, vc)
        cross = jnp.einsum('bhqd,bhdv->bhqv', qc, state) * q_decay
        state = state * chunk_decay + jnp.einsum('bhkd,bhkv->bhdv', kc * k_decay, vc)
        return state, intra + cross

    state0 = jnp.zeros((b, h, dk, dv), jnp.float32)
    _, ys = lax.scan(step, state0, (to_chunks(q), to_chunks(k), to_chunks(v)))
    return ys.transpose(1, 0, 3, 2, 4).reshape(b, s, h, dv).astype(q.dtype)


def odd_mixer(x, w_in, w_out, norm_g):
    b, s, _ = x.shape
    q, k, v, g = jnp.split(x @ w_in, [RET_QK, 2 * RET_QK, 2 * RET_QK + RET_VW], axis=-1)
    q = rotary(q.reshape(b, s, RET_HEADS, RET_DK), RET_DK, RET_ROPE_THETA)
    k = rotary(k.reshape(b, s, RET_HEADS, RET_DK), RET_DK, RET_ROPE_THETA) * (RET_DK ** -0.5)
    v = v.reshape(b, s, RET_HEADS, RET_DV)
    y = retention(q, k, v)
    yf = y.astype(jnp.float32)
    mu = jnp.mean(yf, -1, keepdims=True)
    var = jnp.mean(jnp.square(yf - mu), -1, keepdims=True)
    y = ((yf - mu) * lax.rsqrt(var + LN_EPS)).astype(x.dtype).reshape(b, s, RET_VW) * norm_g
    return (jax.nn.silu(g) * y) @ w_out


def setup_inputs(seed: int = 0) -> dict:
    key = jax.random.key(seed)
    ks = jax.random.split(key, 14)
    beta = DEEPNORM_BETA
    x = jax.random.normal(ks[0], (BATCH, SEQ, D_MODEL), jnp.float32)
    ln_g = 1.0 + 0.02 * jax.random.normal(ks[1], (DEPTH, 3, D_MODEL), jnp.float32)
    ln_b = 0.02 * jax.random.normal(ks[2], (DEPTH, 3, D_MODEL), jnp.float32)
    ffn_w_in = jax.random.normal(ks[3], (DEPTH, 2, D_MODEL, 2 * D_FF), jnp.float32) * (D_MODEL ** -0.5 * beta)
    ffn_w_out = jax.random.normal(ks[4], (DEPTH, 2, D_FF, D_MODEL), jnp.float32) * (D_FF ** -0.5 * beta)
    even_scale = jnp.concatenate([
        jnp.ones((2 * DIFF_QK,), jnp.float32),
        jnp.full((DIFF_WIDTH,), beta, jnp.float32),
        jnp.ones((2 * CONV_CH,), jnp.float32),
        jnp.full((CONV_CH,), beta, jnp.float32)])
    even_w_in = jax.random.normal(ks[5], (N_EVEN, D_MODEL, EVEN_IN), jnp.float32) * (D_MODEL ** -0.5) * even_scale
    even_w_out = jax.random.normal(ks[6], (N_EVEN, DIFF_WIDTH + CONV_CH, D_MODEL), jnp.float32) * ((DIFF_WIDTH + CONV_CH) ** -0.5 * beta)
    diff_lambda = 0.1 * jax.random.normal(ks[7], (N_EVEN, 4, DIFF_DH), jnp.float32)
    diff_norm_g = 1.0 + 0.02 * jax.random.normal(ks[8], (N_EVEN, DIFF_DV), jnp.float32)
    conv_w = jax.random.normal(ks[9], (N_EVEN, CONV_WIDTH, CONV_CH), jnp.float32) * (CONV_WIDTH ** -0.5)
    odd_scale = jnp.concatenate([
        jnp.ones((2 * RET_QK,), jnp.float32),
        jnp.full((RET_VW,), beta, jnp.float32),
        jnp.ones((RET_VW,), jnp.float32)])
    odd_w_in = jax.random.normal(ks[10], (N_ODD, D_MODEL, ODD_IN), jnp.float32) * (D_MODEL ** -0.5) * odd_scale
    odd_w_out = jax.random.normal(ks[11], (N_ODD, RET_VW, D_MODEL), jnp.float32) * (RET_VW ** -0.5 * beta)
    ret_norm_g = 1.0 + 0.02 * jax.random.normal(ks[12], (N_ODD, RET_VW), jnp.float32)
    return {"x": x, "ln_g": ln_g, "ln_b": ln_b, "ffn_w_in": ffn_w_in, "ffn_w_out": ffn_w_out,
            "even_w_in": even_w_in, "even_w_out": even_w_out, "diff_lambda": diff_lambda,
            "diff_norm_g": diff_norm_g, "conv_w": conv_w, "odd_w_in": odd_w_in,
            "odd_w_out": odd_w_out, "ret_norm_g": ret_norm_g}


def reference(x, ln_g, ln_b, ffn_w_in, ffn_w_out, even_w_in, even_w_out, diff_lambda,
              diff_norm_g, conv_w, odd_w_in, odd_w_out, ret_norm_g):
    a = DEEPNORM_ALPHA
    for i in range(DEPTH):
        j = i // 2
        x = layer_norm(a * x + 0.5 * swiglu_ffn(x, ffn_w_in[i, 0], ffn_w_out[i, 0]), ln_g[i, 0], ln_b[i, 0])
        if i % 2 == 0:
            mix = even_mixer(x, even_w_in[j], even_w_out[j], diff_lambda[j], diff_norm_g[j], conv_w[j], i)
        else:
            mix = odd_mixer(x, odd_w_in[j], odd_w_out[j], ret_norm_g[j])
        x = layer_norm(a * x + mix, ln_g[i, 1], ln_b[i, 1])
        x = layer_norm(a * x + 0.5 * swiglu_ffn(x, ffn_w_in[i, 1], ffn_w_out[i, 1]), ln_g[i, 2], ln_b[i, 2])
    return x
```

```cpp
#include <hip/hip_runtime.h>
#include <hip/hip_cooperative_groups.h>
#include <cstdio>
#include <cstdint>
namespace cg = cooperative_groups;
namespace pg8 {
#define PG8_LAS __attribute__((address_space(3)))
typedef unsigned short bf16_t;
typedef short bf16x8 __attribute__((ext_vector_type(8)));
typedef float f32x4 __attribute__((ext_vector_type(4)));
typedef unsigned u32x4 __attribute__((ext_vector_type(4)));
constexpr int BM = 256, BK = 64, HALF = 128, HTB = HALF * BK * 2  , STAGE_BYTES = 8 * HTB, NXCD = 8, WGM = 8;

__host__ __device__ __forceinline__ int lds_byte(int r, int c) { const int st = (r >> 4) * 2 + (c >> 5), rr = r & 15, cc = c & 31, ob = rr * 64 + cc * 2; return st * 1024 + (ob ^ (((ob >> 9) & 1) << 5)); }
__host__ __device__ __forceinline__ void stage_rc(int b, int& R, int& C) { const int st = b / 1024, sb = b % 1024, swz = sb ^ (((sb >> 9) & 1) << 5); R = (st >> 1) * 16 + swz / 64; C = (st & 1) * 32 + (swz % 64) / 2; }
__host__ __device__ __forceinline__ int perm32(int rho) { const int n = rho >> 4, i = rho & 15; return 8 * (i >> 2) + 4 * n + (i & 3); }

struct Unit { int pm, pn; };
struct Gemm { const bf16_t* A; const bf16_t* Bt; int M, N, K; };

struct StaticOrder {
    int nM, nN, nwg, G, c;
    __host__ __device__ void init(int M, int N, int G_, int c_) { nM = M / BM; nN = N / BM; nwg = nM * nN; G = G_; c = c_; }
    __host__ __device__ bool next(int i, Unit& u) const {
        const long L = (long)i * G + c; if (L >= nwg) return false;
        int wgid = (int)L; { const int q = nwg / NXCD, r = nwg % NXCD, xcd = wgid % NXCD, off = wgid / NXCD; wgid = (xcd < r ? xcd * (q + 1) : r * (q + 1) + (xcd - r) * q) + off; }
        const int nig = WGM * nN, gid = wgid / nig, fm = gid * WGM, gsz = (nM - fm) < WGM ? (nM - fm) : WGM;
        u.pm = fm + ((wgid % nig) % gsz); u.pn = (wgid % nig) / gsz; return true;
    }
    __device__ __forceinline__ void a_ready(const Unit&) const {}
    __device__ __forceinline__ void done(const Unit&) const {}
};

__device__ __forceinline__ unsigned cvt_pk_bf16(float lo, float hi) { unsigned r; asm volatile("v_cvt_pk_bf16_f32 %0, %1, %2" : "=v"(r) : "v"(lo), "v"(hi)); return r; }
__device__ __forceinline__ float silu_f(float v) { return v * __builtin_amdgcn_rcpf(1.0f + __builtin_amdgcn_exp2f(-1.4426950408889634f * v)); }
__device__ __forceinline__ f32x4 silu4(f32x4 v) { return (f32x4){silu_f(v[0]), silu_f(v[1]), silu_f(v[2]), silu_f(v[3])}; }
__device__ __forceinline__ u32x4 pack8(f32x4 v0, f32x4 v1) { u32x4 w; w.x = cvt_pk_bf16(v0[0], v0[1]); w.y = cvt_pk_bf16(v0[2], v0[3]); w.z = cvt_pk_bf16(v1[0], v1[1]); w.w = cvt_pk_bf16(v1[2], v1[3]); return w; }

struct EpiSwiglu {
    static constexpr bool PERM = true, AFTER_DRAIN = false;
    bf16_t* H; int ldc;
    __device__ __forceinline__ void operator()(const f32x4 (&acc)[2][2][4][2], const Unit& u, int wr, int wc, int fr, int fq) const {
        const int row0 = u.pm * BM + wr * 64 + fr, col0 = u.pn * HALF + wc * 32 + 8 * fq;
#pragma unroll
        for (int ai = 0; ai < 2; ++ai)
#pragma unroll
            for (int m = 0; m < 4; ++m) { bf16_t* rowp = H + (size_t)(row0 + ai * HALF + m * 16) * ldc + col0;
                const f32x4 h0 = silu4(acc[ai][0][m][0]) * acc[ai][1][m][0], h1 = silu4(acc[ai][0][m][1]) * acc[ai][1][m][1];
                *(u32x4*)rowp = pack8(h0, h1); }
    }
};
struct EpiEvenIn {
    static constexpr bool PERM = true, AFTER_DRAIN = false;
    bf16_t* base; size_t seg_stride; const float* cosT; const float* sinT; float qscale;
    __device__ __forceinline__ void operator()(const f32x4 (&acc)[2][2][4][2], const Unit& u, int wr, int wc, int fr, int fq) const {
        const int t = u.pn >> 1, colseg = (u.pn & 1) * 256 + wc * 32 + 8 * fq, row0 = u.pm * BM + wr * 64 + fr;
        bf16_t* ob = base + (size_t)t * seg_stride;
        const bool rot = (t < 2) && ((wc & 1) == 0) && (fq < 2);
        const float sc = (t == 0) ? qscale : 1.0f;
#pragma unroll
        for (int ai = 0; ai < 2; ++ai)
#pragma unroll
            for (int m = 0; m < 4; ++m) { const int row = row0 + ai * HALF + m * 16, pos = row & 2047;
                f32x4 cs = (f32x4){1.f, 1.f, 1.f, 1.f}, sn = (f32x4){0.f, 0.f, 0.f, 0.f};
                if (rot) { cs = *(const f32x4*)(cosT + pos * 8 + 4 * fq); sn = *(const f32x4*)(sinT + pos * 8 + 4 * fq); }
#pragma unroll
                for (int bj = 0; bj < 2; ++bj) { const f32x4 x1 = acc[ai][bj][m][0], x2 = acc[ai][bj][m][1];
                    const f32x4 y1 = (x1 * cs - x2 * sn) * sc, y2 = (x2 * cs + x1 * sn) * sc;
                    *(u32x4*)(ob + (size_t)row * 512 + colseg + bj * HALF) = pack8(y1, y2); } }
    }
};
struct EpiOddIn {
    static constexpr bool PERM = true, AFTER_DRAIN = false;
    bf16_t *RQ, *RK, *RV, *RG; const float* cosT; const float* sinT;
    __device__ __forceinline__ void operator()(const f32x4 (&acc)[2][2][4][2], const Unit& u, int wr, int wc, int fr, int fq) const {
        const int pn = u.pn, d0 = wc * 32 + 8 * fq, row0 = u.pm * BM + wr * 64 + fr;
        if (pn < 8) {
            bf16_t* ob = (pn < 4) ? RQ : RK; const int hcol = (pn & 3) * 256 + d0; const float sc = (pn < 4) ? 1.0f : 0.0625f;
#pragma unroll
            for (int ai = 0; ai < 2; ++ai)
#pragma unroll
                for (int m = 0; m < 4; ++m) { const int row = row0 + ai * HALF + m * 16, pos = row & 2047;
                    f32x4 y1[2], y2[2];
#pragma unroll
                    for (int n = 0; n < 2; ++n) { const f32x4 cs = *(const f32x4*)(cosT + pos * 128 + d0 + 4 * n), sn = *(const f32x4*)(sinT + pos * 128 + d0 + 4 * n);
                        const f32x4 x1 = acc[ai][0][m][n], x2 = acc[ai][1][m][n];
                        y1[n] = (x1 * cs - x2 * sn) * sc; y2[n] = (x2 * cs + x1 * sn) * sc; }
                    *(u32x4*)(ob + (size_t)row * 1024 + hcol) = pack8(y1[0], y1[1]);
                    *(u32x4*)(ob + (size_t)row * 1024 + hcol + HALF) = pack8(y2[0], y2[1]); }
        } else {
            bf16_t* ob = (pn < 16) ? RV : RG; const int colt = (pn & 7) * 256 + d0; const bool act = pn >= 16;
#pragma unroll
            for (int ai = 0; ai < 2; ++ai)
#pragma unroll
                for (int m = 0; m < 4; ++m) { const int row = row0 + ai * HALF + m * 16;
#pragma unroll
                    for (int bj = 0; bj < 2; ++bj) { f32x4 v0 = acc[ai][bj][m][0], v1 = acc[ai][bj][m][1];
                        if (act) { v0 = silu4(v0); v1 = silu4(v1); }
                        *(u32x4*)(ob + (size_t)row * 2048 + colt + bj * HALF) = pack8(v0, v1); } }
        }
    }
};
struct EpiResid {
    static constexpr bool PERM = false, AFTER_DRAIN = false;
    const float* base; float* out; float a, s;
    __device__ __forceinline__ void operator()(const f32x4 (&acc)[2][2][4][2], const Unit& u, int wr, int wc, int fr, int fq) const {
        const int col0 = u.pn * BM + wc * 32 + 4 * fq, row0 = u.pm * BM + wr * 64 + fr;
#pragma unroll
        for (int ai = 0; ai < 2; ++ai)
#pragma unroll
            for (int m = 0; m < 4; ++m) { const size_t off = (size_t)(row0 + ai * HALF + m * 16) * 1024 + col0;
#pragma unroll
                for (int bj = 0; bj < 2; ++bj)
#pragma unroll
                    for (int n = 0; n < 2; ++n) { const f32x4 b = *(const f32x4*)(base + off + bj * HALF + n * 16);
                        *(f32x4*)(out + off + bj * HALF + n * 16) = b * a + acc[ai][bj][m][n] * s; } }
    }
};

template <class Epi, class Sched, bool ALIGN_EPI = false, bool SP2 = false>
__device__ __forceinline__ void gemm_phase(PG8_LAS unsigned char* lds, const Gemm g, const Sched& S, const Epi& E) {
    int tid_ = threadIdx.x; asm volatile("" : "+v"(tid_));
    const int tid = tid_, wid = __builtin_amdgcn_readfirstlane(tid >> 6), lane = tid & 63, wr = wid >> 2, wc = wid & 3, fr = lane & 15, fq = lane >> 4;
    const int K = g.K, nt = K / BK;
    unsigned voffA[2], voffB[2];
#pragma unroll
    for (int i = 0; i < 2; ++i) { int R, C; stage_rc(tid * 16 + i * 8192, R, C); const int Rb = Epi::PERM ? ((R & ~31) + perm32(R & 31)) : R;
        voffA[i] = (unsigned)(R * K + C) * 2u; voffB[i] = (unsigned)(Rb * K + C) * 2u; }
    const size_t kstep = (size_t)(BK * 2);
    const size_t hstep = (size_t)HALF * K * 2;
    const size_t tstep = 2 * hstep;
    const unsigned ldsw = (unsigned)wid * 1024u;
    const int aoff = lds_byte(wr * 64 + fr, fq * 8), boff = lds_byte(wc * 32 + fr, fq * 8);
#define PG8_SA(b, h) (((b) * 2 + (h)) * HTB)
#define PG8_SB(b, h) ((4 + (b) * 2 + (h)) * HTB)
#define PG8_STAGE(bufoff, gbase, voff) do { _Pragma("unroll") for (int _i = 0; _i < 2; ++_i) \
        __builtin_amdgcn_global_load_lds((const unsigned*)((const char*)(gbase) + (voff)[_i]), (PG8_LAS unsigned*)(lds + (bufoff) + ldsw + _i * 8192), 16, 0, 0); } while (0)
#define PG8_LDA(dst, b, h) do { _Pragma("unroll") for (int m = 0; m < 4; ++m) _Pragma("unroll") for (int k = 0; k < 2; ++k) dst[m][k] = *(const PG8_LAS bf16x8*)(lds + PG8_SA(b, h) + aoff + m * 2048 + k * 1024); } while (0)
#define PG8_LDB(dst, b, h) do { _Pragma("unroll") for (int n = 0; n < 2; ++n) _Pragma("unroll") for (int k = 0; k < 2; ++k) dst[n][k] = *(const PG8_LAS bf16x8*)(lds + PG8_SB(b, h) + boff + n * 2048 + k * 1024); } while (0)
#define PG8_MMA(ai, bj, At, Bt) do { __builtin_amdgcn_s_setprio(1); _Pragma("unroll") for (int m = 0; m < 4; ++m) _Pragma("unroll") for (int n = 0; n < 2; ++n) _Pragma("unroll") for (int k = 0; k < 2; ++k) \
        acc[ai][bj][m][n] = __builtin_amdgcn_mfma_f32_16x16x32_bf16(Bt[n][k], At[m][k], acc[ai][bj][m][n], 0, 0, 0); __builtin_amdgcn_s_setprio(0); } while (0)
#define PG8_WAIT_V(n) asm volatile("s_waitcnt vmcnt(" #n ")" ::: "memory")
#define PG8_WAIT_L(n) asm volatile("s_waitcnt lgkmcnt(" #n ")" ::: "memory")
#define PG8_BAR __builtin_amdgcn_s_barrier()
#define PG8_SCHED __builtin_amdgcn_sched_barrier(0)
    Unit cur, nxt; int ui = 0;
    if (!S.next(0, cur)) return;
    f32x4 acc[2][2][4][2];
#pragma unroll
    for (int a = 0; a < 2; ++a)
#pragma unroll
        for (int b = 0; b < 2; ++b)
#pragma unroll
            for (int m = 0; m < 4; ++m)
#pragma unroll
                for (int n = 0; n < 2; ++n) acc[a][b][m][n] = (f32x4){0.f, 0.f, 0.f, 0.f};
    bf16x8 At[4][2], B0[2][2], B1[2][2];
    const char* cA = (const char*)g.A + (size_t)cur.pm * tstep; const char* cB = (const char*)g.Bt + (size_t)cur.pn * tstep;
    S.a_ready(cur);
    if constexpr (SP2) {
        PG8_STAGE(PG8_SB(0, 0), cB, voffB); PG8_STAGE(PG8_SB(0, 1), cB + hstep, voffB); PG8_STAGE(PG8_SA(0, 0), cA, voffA); PG8_STAGE(PG8_SA(0, 1), cA + hstep, voffA);
        if (wr == 1) PG8_BAR;
        PG8_WAIT_V(2); PG8_BAR;
        PG8_STAGE(PG8_SB(1, 0), cB + kstep, voffB); PG8_STAGE(PG8_SA(1, 0), cA + kstep, voffA); PG8_STAGE(PG8_SB(1, 1), cB + hstep + kstep, voffB);
        PG8_WAIT_V(6); PG8_BAR;
    } else {
        PG8_STAGE(PG8_SB(0, 0), cB, voffB); PG8_STAGE(PG8_SA(0, 0), cA, voffA); PG8_STAGE(PG8_SB(0, 1), cB + hstep, voffB); PG8_STAGE(PG8_SA(0, 1), cA + hstep, voffA);
        if (wr == 1) PG8_BAR;
        PG8_WAIT_V(4); PG8_BAR;
        PG8_STAGE(PG8_SB(1, 0), cB + kstep, voffB); PG8_STAGE(PG8_SA(1, 0), cA + kstep, voffA); PG8_STAGE(PG8_SB(1, 1), cB + hstep + kstep, voffB);
        PG8_WAIT_V(6); PG8_BAR;
    }
    for (;;) {
        const bool has_next = S.next(ui + 1, nxt);
        const char* nA = has_next ? (const char*)g.A + (size_t)nxt.pm * tstep : cA; const char* nB = has_next ? (const char*)g.Bt + (size_t)nxt.pn * tstep : cB;
        for (int t = 0; t < nt; t += 2) {
            const bool last = (t == nt - 2);
            const char* a1 = cA + (size_t)(t + 1) * kstep;
            const char* a2 = last ? nA : cA + (size_t)(t + 2) * kstep; const char* b2 = last ? nB : cB + (size_t)(t + 2) * kstep;
            const char* a3 = a2 + kstep; const char* b3 = b2 + kstep;
            if (last && has_next) S.a_ready(nxt);
            if constexpr (SP2) {
            PG8_LDB(B0, 0, 0); PG8_LDB(B1, 0, 1); PG8_SCHED; PG8_LDA(At, 0, 0); PG8_STAGE(PG8_SA(1, 1), a1 + hstep, voffA);
            PG8_WAIT_V(8); PG8_WAIT_L(0); PG8_BAR; PG8_MMA(0, 0, At, B0); PG8_MMA(0, 1, At, B1); PG8_BAR; PG8_SCHED;
            PG8_LDA(At, 0, 1); PG8_STAGE(PG8_SB(0, 0), b2, voffB); PG8_STAGE(PG8_SB(0, 1), b2 + hstep, voffB); PG8_STAGE(PG8_SA(0, 0), a2, voffA);
            PG8_WAIT_V(8); PG8_WAIT_L(0); PG8_BAR; PG8_MMA(1, 0, At, B0); PG8_MMA(1, 1, At, B1); PG8_BAR; PG8_SCHED;
            PG8_LDB(B0, 1, 0); PG8_LDB(B1, 1, 1); PG8_SCHED; PG8_LDA(At, 1, 0); PG8_STAGE(PG8_SA(0, 1), a2 + hstep, voffA);
            PG8_WAIT_V(8); PG8_WAIT_L(0); PG8_BAR; PG8_MMA(0, 0, At, B0); PG8_MMA(0, 1, At, B1); PG8_BAR; PG8_SCHED;
            PG8_LDA(At, 1, 1); PG8_STAGE(PG8_SB(1, 0), b3, voffB); PG8_STAGE(PG8_SB(1, 1), b3 + hstep, voffB); PG8_STAGE(PG8_SA(1, 0), a3, voffA);
            PG8_WAIT_V(8); PG8_WAIT_L(0); PG8_BAR; PG8_MMA(1, 0, At, B0); PG8_MMA(1, 1, At, B1); PG8_BAR; PG8_SCHED;
            } else {
            PG8_LDB(B0, 0, 0); PG8_SCHED; PG8_LDA(At, 0, 0); PG8_STAGE(PG8_SA(1, 1), a1 + hstep, voffA);
            PG8_WAIT_L(8); PG8_BAR; PG8_WAIT_L(0); PG8_MMA(0, 0, At, B0); PG8_BAR; PG8_SCHED;
            PG8_LDB(B1, 0, 1); PG8_STAGE(PG8_SB(0, 0), b2, voffB);
            PG8_BAR; PG8_WAIT_L(0); PG8_MMA(0, 1, At, B1); PG8_BAR;
            PG8_LDA(At, 0, 1); PG8_STAGE(PG8_SA(0, 0), a2, voffA);
            PG8_BAR; PG8_WAIT_L(0); PG8_MMA(1, 0, At, B0); PG8_BAR; PG8_SCHED;
            PG8_STAGE(PG8_SB(0, 1), b2 + hstep, voffB);
            PG8_WAIT_V(6); PG8_BAR; PG8_MMA(1, 1, At, B1); PG8_BAR;
            PG8_LDB(B0, 1, 0); PG8_SCHED; PG8_LDA(At, 1, 0); PG8_STAGE(PG8_SA(0, 1), a2 + hstep, voffA);
            PG8_WAIT_L(8); PG8_BAR; PG8_WAIT_L(0); PG8_MMA(0, 0, At, B0); PG8_BAR; PG8_SCHED;
            PG8_LDB(B1, 1, 1); PG8_STAGE(PG8_SB(1, 0), b3, voffB);
            PG8_BAR; PG8_WAIT_L(0); PG8_MMA(0, 1, At, B1); PG8_BAR;
            PG8_LDA(At, 1, 1); PG8_STAGE(PG8_SA(1, 0), a3, voffA);
            PG8_BAR; PG8_WAIT_L(0); PG8_MMA(1, 0, At, B0); PG8_BAR; PG8_SCHED;
            PG8_STAGE(PG8_SB(1, 1), b3 + hstep, voffB);
            PG8_WAIT_V(6); PG8_BAR; PG8_MMA(1, 1, At, B1); PG8_BAR;
            }
        }
        if constexpr (ALIGN_EPI) { if (wr == 0) PG8_BAR; }
        if constexpr (!Epi::AFTER_DRAIN) { E(acc, cur, wr, wc, fr, fq); S.done(cur); }
        if (!has_next) break;
#pragma unroll
        for (int a = 0; a < 2; ++a)
#pragma unroll
            for (int b = 0; b < 2; ++b)
#pragma unroll
                for (int m = 0; m < 4; ++m)
#pragma unroll
                    for (int n = 0; n < 2; ++n) acc[a][b][m][n] = (f32x4){0.f, 0.f, 0.f, 0.f};
        cur = nxt; cA = nA; cB = nB; ++ui;
        if constexpr (ALIGN_EPI) { if (wr == 1) PG8_BAR; }
    }
    PG8_WAIT_V(0);
    if constexpr (!ALIGN_EPI) { if (wr == 0) PG8_BAR; }
    PG8_BAR;
    if constexpr (Epi::AFTER_DRAIN) { E.fused(acc, cur, wr, wc, fr, fq, lds, wid, lane); S.done(cur); }
#undef PG8_SA
#undef PG8_SB
#undef PG8_STAGE
#undef PG8_LDA
#undef PG8_LDB
#undef PG8_MMA
#undef PG8_WAIT_V
#undef PG8_WAIT_L
#undef PG8_BAR
#undef PG8_SCHED
}
}
constexpr int NWAVES = 8;
constexpr int M = 16384, D = 1024, SEQ = 2048, DFF = 2816;
constexpr float LN_EPS = 1e-5f;
constexpr float ALPHA = 1.41421356237309515f;
constexpr float QSCALE = 0.125f * 1.4426950408889634f;
constexpr float LAMBDA_INIT = 0.2f;
constexpr size_t MiB = 1u << 20;
constexpr size_t WS_ECOS = 1 * MiB, WS_ESIN = 1 * MiB + 65536, WS_OCOS = 2 * MiB, WS_OSIN = 3 * MiB;
constexpr size_t WS_OWIN = 37 * MiB, WS_OWOUT = 49 * MiB, WS_EWIN = 86 * MiB, WS_EWOUT = 92 * MiB;
constexpr size_t WS_XB = 94 * MiB, WS_ACT = 126 * MiB;
constexpr size_t WS_H = WS_ACT;
constexpr size_t WS_EQ = WS_ACT, WS_EO = WS_ACT + 96 * MiB, WS_CAT = WS_ACT;
constexpr size_t WS_RQ = WS_ACT, WS_RK = WS_ACT + 32 * MiB, WS_RV = WS_ACT + 64 * MiB, WS_RG = WS_ACT + 128 * MiB;
constexpr size_t WS_YN = 53 * MiB;
constexpr size_t WS_END = 318 * MiB;
__host__ __device__ __forceinline__ size_t w1t_off(int idx) { return idx >= 2 ? (4 + (size_t)(idx - 2) * 11) * MiB : (53 + (size_t)idx * 11) * MiB; }
__host__ __device__ __forceinline__ size_t w2t_off(int idx) { return idx >= 2 ? 26 * MiB + (size_t)(idx - 2) * (MiB * 11 / 2) : 75 * MiB + (size_t)idx * (MiB * 11 / 2); }
constexpr int LDS_BYTES = 147456;

#define LAS __attribute__((address_space(3)))
typedef unsigned short bf16;
typedef unsigned v4u __attribute__((ext_vector_type(4)));
typedef unsigned v2u __attribute__((ext_vector_type(2)));
typedef float f32x4 __attribute__((ext_vector_type(4)));
#define LDS_WAIT() asm volatile("s_waitcnt lgkmcnt(0)" ::: "memory")
__device__ __forceinline__ unsigned f2bf(float f) { unsigned u = __builtin_bit_cast(unsigned, f); return (u + 0x7fffu + ((u >> 16) & 1u)) >> 16; }
__device__ __forceinline__ unsigned pk2(float lo, float hi) { return f2bf(lo) | (f2bf(hi) << 16); }
__device__ __forceinline__ float bflo(unsigned u) { return __builtin_bit_cast(float, u << 16); }
__device__ __forceinline__ float bfhi(unsigned u) { return __builtin_bit_cast(float, u & 0xffff0000u); }
__device__ __forceinline__ int opq(int v) { asm volatile("" : "+v"(v)); return v; }
__device__ __forceinline__ float wave_sum(float v) {
#pragma unroll
    for (int o = 1; o < 64; o <<= 1) v += __shfl_xor(v, o);
    return v;
}
__device__ __forceinline__ float wave_max(float v) {
#pragma unroll
    for (int o = 1; o < 64; o <<= 1) v = fmaxf(v, __shfl_xor(v, o));
    return v;
}

__device__ __forceinline__ int colmap(int mode, int n) {
    if (mode == 1) return (n >> 8) * 128 + (n & 127) + ((n >> 7) & 1) * DFF;
    if (mode == 2) { if (n < 1024) { const int p = n & 63; if (p < 16) { const int q = p >> 2; return n + (q == 1 ? 4 : (q == 2 ? -4 : 0)); } } return n; }
    return n;
}
__device__ __forceinline__ void p0_transpose_item(const float* W, int K, int N, bf16* WT, int mode, LAS float* scr, int item, int lane) {
    const int nblk = N / 32, kb = item / nblk, nb = item % nblk, k0 = 64 * kb, n0 = 32 * nb;
    const int sc = colmap(mode, n0 + (lane & 31));
#pragma unroll 8
    for (int i = 0; i < 32; ++i) { const int kk = 2 * i + (lane >> 5); scr[kk * 33 + (lane & 31)] = W[(size_t)(k0 + kk) * N + sc]; }
    LDS_WAIT(); asm volatile("" ::: "memory");
    const int c = lane & 7;
#pragma unroll
    for (int j = 0; j < 4; ++j) { const int n = (lane >> 3) + 8 * j; const LAS float* s = scr + (8 * c) * 33 + n;
        v4u o; o.x = pk2(s[0 * 33], s[1 * 33]); o.y = pk2(s[2 * 33], s[3 * 33]); o.z = pk2(s[4 * 33], s[5 * 33]); o.w = pk2(s[6 * 33], s[7 * 33]);
        *(v4u*)(WT + (size_t)(n0 + n) * K + k0 + 8 * c) = o; }
    LDS_WAIT(); asm volatile("" ::: "memory");
}

__device__ __forceinline__ void ln_row(const float* xrow, float* orow, bf16* brow, const float* g, const float* b, int lane) {
    const f32x4* xr = (const f32x4*)xrow + lane;
    f32x4 v[4]; float s = 0.f;
#pragma unroll
    for (int j = 0; j < 4; ++j) { v[j] = xr[64 * j]; s += (v[j].x + v[j].y) + (v[j].z + v[j].w); }
    const float mean = wave_sum(s) * (1.f / D); float s2 = 0.f;
#pragma unroll
    for (int j = 0; j < 4; ++j) { v[j] = v[j] - mean; s2 += (v[j].x * v[j].x + v[j].y * v[j].y) + (v[j].z * v[j].z + v[j].w * v[j].w); }
    const float rstd = 1.f / sqrtf(wave_sum(s2) * (1.f / D) + LN_EPS);
#pragma unroll
    for (int j = 0; j < 4; ++j) { const f32x4 gg = ((const f32x4*)g)[lane + 64 * j], bb = ((const f32x4*)b)[lane + 64 * j];
        const f32x4 y = v[j] * rstd * gg + bb;
        ((f32x4*)orow)[lane + 64 * j] = y;
        v2u o; o.x = pk2(y.x, y.y); o.y = pk2(y.z, y.w); ((v2u*)brow)[lane + 64 * j] = o; }
}

__device__ __forceinline__ void attn_naive(const bf16* Q, const bf16* K, const bf16* V, bf16* O, LAS float* sc, int gw, int NGW, int lane) {
    for (int item = gw; item < M * 8; item += NGW) {
        const int row = item >> 3, c = item & 7, b = row >> 11, t = row & 2047;
        const v4u* qp = (const v4u*)(Q + (size_t)row * 512 + c * 64);
        v4u q[8];
#pragma unroll
        for (int i = 0; i < 8; ++i) q[i] = qp[i];
        const bf16* Kb = K + (size_t)(b * SEQ) * 512 + c * 64;
        float mx = -INFINITY;
        for (int s0 = 0; s0 <= t; s0 += 64) { const int s = s0 + lane; float d = -INFINITY;
            if (s <= t) { const v4u* kp = (const v4u*)(Kb + (size_t)s * 512); float a = 0.f;
#pragma unroll
                for (int i = 0; i < 8; ++i) { const v4u kk = kp[i];
#pragma unroll
                    for (int w = 0; w < 4; ++w) a += bflo(q[i][w]) * bflo(kk[w]) + bfhi(q[i][w]) * bfhi(kk[w]); }
                d = a; }
            sc[s] = d; mx = fmaxf(mx, d); }
        mx = wave_max(mx);
        LDS_WAIT();
        float sum = 0.f;
        for (int s0 = 0; s0 <= t; s0 += 64) { const int s = s0 + lane; const float p = (s <= t) ? __builtin_amdgcn_exp2f(sc[s] - mx) : 0.f; sc[s] = p; sum += p; }
        sum = wave_sum(sum); const float inv = 1.0f / sum;
        LDS_WAIT();
        const bf16* Vb = V + (size_t)(b * SEQ) * 512 + (c >> 1) * 128 + 2 * lane;
        float o0 = 0.f, o1 = 0.f;
#pragma unroll 8
        for (int s = 0; s <= t; ++s) { const float p = sc[s]; const unsigned vv = *(const unsigned*)(Vb + (size_t)s * 512); o0 += p * bflo(vv); o1 += p * bfhi(vv); }
        *(unsigned*)(O + (size_t)row * 1024 + c * 128 + 2 * lane) = pk2(o0 * inv, o1 * inv);
        LDS_WAIT();
    }
}
__device__ __forceinline__ void post_attn(const bf16* O, const bf16* CB, const bf16* CC, const bf16* CX, bf16* CAT, const float* lamv, const float* ng, const float* cw, int gw, int NGW, int lane) {
    float l01 = lamv[lane] * lamv[64 + lane], l23 = lamv[128 + lane] * lamv[192 + lane];
    l01 = wave_sum(l01); l23 = wave_sum(l23);
    const float lam = expf(l01) - expf(l23) + LAMBDA_INIT;
    const float g0 = ng[2 * lane] * (1.0f - LAMBDA_INIT), g1 = ng[2 * lane + 1] * (1.0f - LAMBDA_INIT);
    f32x4 w0a = *(const f32x4*)(cw + 8 * lane), w0b = *(const f32x4*)(cw + 8 * lane + 4);
    f32x4 w1a = *(const f32x4*)(cw + 512 + 8 * lane), w1b = *(const f32x4*)(cw + 512 + 8 * lane + 4);
    f32x4 w2a = *(const f32x4*)(cw + 1024 + 8 * lane), w2b = *(const f32x4*)(cw + 1024 + 8 * lane + 4);
    for (int row = gw; row < M; row += NGW) {
        const int t = row & 2047;
        unsigned outw[4];
#pragma unroll
        for (int h = 0; h < 4; ++h) { const unsigned a = *(const unsigned*)(O + (size_t)row * 1024 + (2 * h) * 128 + 2 * lane), bq = *(const unsigned*)(O + (size_t)row * 1024 + (2 * h + 1) * 128 + 2 * lane);
            const float o0 = bflo(a) - lam * bflo(bq), o1 = bfhi(a) - lam * bfhi(bq);
            const float ss = wave_sum(o0 * o0 + o1 * o1);
            const float r = 1.0f / sqrtf(ss * (1.0f / 128.0f) + LN_EPS);
            outw[h] = pk2(o0 * r * g0, o1 * r * g1); }
        f32x4 ya = (f32x4){0.f, 0.f, 0.f, 0.f}, yb = ya;
#pragma unroll
        for (int k = 0; k < 3; ++k) { const int dt = 2 - k;
            if (t - dt >= 0) { const size_t off = (size_t)(row - dt) * 512 + 8 * lane; const v4u c = *(const v4u*)(CC + off), x = *(const v4u*)(CX + off);
                const f32x4 ua = (f32x4){bflo(c.x) * bflo(x.x), bfhi(c.x) * bfhi(x.x), bflo(c.y) * bflo(x.y), bfhi(c.y) * bfhi(x.y)};
                const f32x4 ub = (f32x4){bflo(c.z) * bflo(x.z), bfhi(c.z) * bfhi(x.z), bflo(c.w) * bflo(x.w), bfhi(c.w) * bfhi(x.w)};
                const f32x4 wa = k == 0 ? w0a : (k == 1 ? w1a : w2a), wb = k == 0 ? w0b : (k == 1 ? w1b : w2b);
                ya += wa * ua; yb += wb * ub; } }
        const v4u cb = *(const v4u*)(CB + (size_t)row * 512 + 8 * lane);
        v4u o; o.x = pk2(bflo(cb.x) * ya.x, bfhi(cb.x) * ya.y); o.y = pk2(bflo(cb.y) * ya.z, bfhi(cb.y) * ya.w); o.z = pk2(bflo(cb.z) * yb.x, bfhi(cb.z) * yb.y); o.w = pk2(bflo(cb.w) * yb.z, bfhi(cb.w) * yb.w);
        bf16* crow = CAT + (size_t)row * 1024;
#pragma unroll
        for (int h = 0; h < 4; ++h) *(unsigned*)(crow + h * 128 + 2 * lane) = outw[h];
        *(v4u*)(crow + 512 + 8 * lane) = o;
    }
}
__device__ __forceinline__ void ret_naive(const bf16* RQ, const bf16* RK, const bf16* RV, bf16* Y, LAS float* qs, LAS float* sc, int gw, int NGW, int lane) {
    for (int item = gw; item < M * 4; item += NGW) {
        const int row = item >> 2, h = item & 3, b = row >> 11, t = row & 2047;
        { const v2u qq = *(const v2u*)(RQ + (size_t)row * 1024 + h * 256 + 4 * lane);
          *(LAS f32x4*)(qs + 4 * lane) = (f32x4){bflo(qq.x), bfhi(qq.x), bflo(qq.y), bfhi(qq.y)}; }
        LDS_WAIT();
        const float l2g = log2f(1.0f - exp2f(-5.0f - (float)h));
        const bf16* Kb = RK + (size_t)(b * SEQ) * 1024 + h * 256;
        for (int s0 = 0; s0 <= t; s0 += 64) { const int s = s0 + lane; float a = 0.f;
            if (s <= t) { const v4u* kp = (const v4u*)(Kb + (size_t)s * 1024);
#pragma unroll 8
                for (int i = 0; i < 32; ++i) { const v4u kk = kp[i]; const f32x4 qa = *(const LAS f32x4*)(qs + 8 * i), qb = *(const LAS f32x4*)(qs + 8 * i + 4);
                    a += bflo(kk.x) * qa.x + bfhi(kk.x) * qa.y + bflo(kk.y) * qa.z + bfhi(kk.y) * qa.w + bflo(kk.z) * qb.x + bfhi(kk.z) * qb.y + bflo(kk.w) * qb.z + bfhi(kk.w) * qb.w; }
                a *= exp2f((float)(t - s) * l2g); }
            sc[s] = a; }
        LDS_WAIT();
        const bf16* Vb = RV + (size_t)(b * SEQ) * 2048 + h * 512 + 8 * lane;
        f32x4 ya = (f32x4){0.f, 0.f, 0.f, 0.f}, yb = ya;
#pragma unroll 4
        for (int s = 0; s <= t; ++s) { const float p = sc[s]; const v4u vv = *(const v4u*)(Vb + (size_t)s * 2048);
            ya += (f32x4){bflo(vv.x), bfhi(vv.x), bflo(vv.y), bfhi(vv.y)} * p; yb += (f32x4){bflo(vv.z), bfhi(vv.z), bflo(vv.w), bfhi(vv.w)} * p; }
        v4u o; o.x = pk2(ya.x, ya.y); o.y = pk2(ya.z, ya.w); o.z = pk2(yb.x, yb.y); o.w = pk2(yb.z, yb.w);
        *(v4u*)(Y + (size_t)row * 2048 + h * 512 + 8 * lane) = o;
        LDS_WAIT();
    }
}
__device__ __forceinline__ void post_ret(const bf16* Y, const bf16* RG, bf16* Z, const float* ng, int gw, int NGW, int lane) {
    for (int item = gw; item < M * 4; item += NGW) {
        const int row = item >> 2, h = item & 3; const size_t off = (size_t)row * 2048 + h * 512 + 8 * lane;
        const v4u yy = *(const v4u*)(Y + off), gg = *(const v4u*)(RG + off);
        f32x4 ya = (f32x4){bflo(yy.x), bfhi(yy.x), bflo(yy.y), bfhi(yy.y)}, yb = (f32x4){bflo(yy.z), bfhi(yy.z), bflo(yy.w), bfhi(yy.w)};
        const float mean = wave_sum((ya.x + ya.y) + (ya.z + ya.w) + (yb.x + yb.y) + (yb.z + yb.w)) * (1.0f / 512.0f);
        ya = ya - mean; yb = yb - mean;
        const float var = wave_sum((ya.x * ya.x + ya.y * ya.y) + (ya.z * ya.z + ya.w * ya.w) + (yb.x * yb.x + yb.y * yb.y) + (yb.z * yb.z + yb.w * yb.w)) * (1.0f / 512.0f);
        const float rstd = 1.0f / sqrtf(var + LN_EPS);
        const f32x4 na = *(const f32x4*)(ng + h * 512 + 8 * lane), nb = *(const f32x4*)(ng + h * 512 + 8 * lane + 4);
        const f32x4 ga = (f32x4){bflo(gg.x), bfhi(gg.x), bflo(gg.y), bfhi(gg.y)}, gb = (f32x4){bflo(gg.z), bfhi(gg.z), bflo(gg.w), bfhi(gg.w)};
        ya = ya * rstd * na * ga; yb = yb * rstd * nb * gb;
        v4u o; o.x = pk2(ya.x, ya.y); o.y = pk2(ya.z, ya.w); o.z = pk2(yb.x, yb.y); o.w = pk2(yb.z, yb.w);
        *(v4u*)(Z + off) = o;
    }
}
#ifndef MK_MULTI
#define MK_MULTI 0
#endif
#ifndef NAIVE_ATTN
#define NAIVE_ATTN 1
#endif
#ifndef NAIVE_RET
#define NAIVE_RET 1
#endif
constexpr int N_PHASES = 23;
struct Args { const float* in[13]; float* out; unsigned char* ws; int ph_lo, ph_hi; };
template <bool COOP>
__global__ void __launch_bounds__(NWAVES * 64, 2) mk_fwd(Args args) {
    extern __shared__ __attribute__((aligned(16))) unsigned char lds[];
    LAS unsigned char* ldsp = (LAS unsigned char*)lds;
    const int tid = threadIdx.x, lane = tid & 63, wave = __builtin_amdgcn_readfirstlane(tid >> 6);
    const int G = gridDim.x, bx = blockIdx.x;
    const int gw = bx * NWAVES + wave, NGW = G * NWAVES;
    unsigned char* ws = args.ws;
    float* out = args.out;
    bf16* XB = (bf16*)(ws + WS_XB);
    const int lo = args.ph_lo, hi = args.ph_hi;
#define IN(k) (lo <= (k) && (k) < hi)
#define GRID_SYNC() do { if (COOP) { cg::this_grid().sync(); } } while (0)

    if (IN(0)) {
        LAS float* scr = (LAS float*)(ldsp + wave * 16384);
        constexpr int I_1 = (D / 64) * (2 * DFF / 32), I_2 = (DFF / 64) * (D / 32), I_EI = (D / 64) * (3072 / 32), I_EO = (D / 64) * (D / 32), I_OI = (D / 64) * (6144 / 32), I_OO = (2048 / 64) * (D / 32);
        constexpr int NITEMS = 4 * I_1 + 4 * I_2 + I_EI + I_EO + I_OI + I_OO;
        for (int it = gw; it < NITEMS; it += NGW) {
            int r = it;
            if (r < 4 * I_1) { const int idx = r / I_1; p0_transpose_item(args.in[3] + (size_t)idx * D * 2 * DFF, D, 2 * DFF, (bf16*)(ws + w1t_off(idx)), 1, scr, r % I_1, lane); continue; } r -= 4 * I_1;
            if (r < 4 * I_2) { const int idx = r / I_2; p0_transpose_item(args.in[4] + (size_t)idx * DFF * D, DFF, D, (bf16*)(ws + w2t_off(idx)), 0, scr, r % I_2, lane); continue; } r -= 4 * I_2;
            if (r < I_EI) { p0_transpose_item(args.in[5], D, 3072, (bf16*)(ws + WS_EWIN), 2, scr, r, lane); continue; } r -= I_EI;
            if (r < I_EO) { p0_transpose_item(args.in[6], D, D, (bf16*)(ws + WS_EWOUT), 0, scr, r, lane); continue; } r -= I_EO;
            if (r < I_OI) { p0_transpose_item(args.in[10], D, 6144, (bf16*)(ws + WS_OWIN), 0, scr, r, lane); continue; } r -= I_OI;
            p0_transpose_item(args.in[11], 2048, D, (bf16*)(ws + WS_OWOUT), 0, scr, r, lane);
        }
        for (int m = gw; m < M; m += NGW) {
            const f32x4* xr = (const f32x4*)(args.in[0] + (size_t)m * D) + lane;
#pragma unroll
            for (int j = 0; j < 4; ++j) { const f32x4 v = xr[64 * j]; v2u o; o.x = pk2(v.x, v.y); o.y = pk2(v.z, v.w); ((v2u*)(XB + (size_t)m * D))[lane + 64 * j] = o; }
        }
        { float* ecos = (float*)(ws + WS_ECOS); float* esin = (float*)(ws + WS_ESIN); float* ocos = (float*)(ws + WS_OCOS); float* osin = (float*)(ws + WS_OSIN);
          const int gt = bx * (NWAVES * 64) + tid, NGT = G * NWAVES * 64;
          for (int e = gt; e < SEQ * 8; e += NGT) { const int pos = e >> 3, i = e & 7; const float inv = expf((-13.122363377404328f * (float)i) * 0.125f); const float ang = (float)pos * inv; ecos[e] = cosf(ang); esin[e] = sinf(ang); }
          for (int e = gt; e < SEQ * 128; e += NGT) { const int pos = e >> 7, i = e & 127; const float inv = expf((-9.210340371976184f * (float)i) * 0.0078125f); const float ang = (float)pos * inv; ocos[e] = cosf(ang); osin[e] = sinf(ang); } }
        GRID_SYNC();
    }
    for (int layer = 0; layer < 2; ++layer) {
        const int pb = 1 + 11 * layer;
        const float* lng = args.in[1] + (size_t)layer * 3 * D; const float* lnb = args.in[2] + (size_t)layer * 3 * D;
#define FFN_STEP(slot, ph0, lnk) do { \
        const int idx_ = layer * 2 + (slot); \
        if (IN(pb + (ph0))) { pg8::Gemm g{XB, (const bf16*)(ws + w1t_off(idx_)), M, 2 * DFF, D}; pg8::StaticOrder S; S.init(M, 2 * DFF, G, bx); \
            pg8::EpiSwiglu E{(bf16*)(ws + WS_H), DFF}; pg8::gemm_phase<pg8::EpiSwiglu, pg8::StaticOrder, true, true>(ldsp, g, S, E); GRID_SYNC(); } \
        if (IN(pb + (ph0) + 1)) { pg8::Gemm g{(const bf16*)(ws + WS_H), (const bf16*)(ws + w2t_off(idx_)), M, D, DFF}; pg8::StaticOrder S; S.init(M, D, G, bx); \
            pg8::EpiResid E{(layer == 0 && (slot) == 0) ? args.in[0] : out, out, ALPHA, 0.5f}; pg8::gemm_phase<pg8::EpiResid, pg8::StaticOrder, true, true>(ldsp, g, S, E); GRID_SYNC(); } \
        if (IN(pb + (ph0) + 2)) { for (int m = gw; m < M; m += NGW) ln_row(out + (size_t)m * D, out + (size_t)m * D, XB + (size_t)m * D, lng + (lnk) * D, lnb + (lnk) * D, opq(lane)); GRID_SYNC(); } \
    } while (0)
        FFN_STEP(0, 0, 0);
        if (layer == 0) {
            bf16* EQ = (bf16*)(ws + WS_EQ);
            if (IN(pb + 3)) { pg8::Gemm g{XB, (const bf16*)(ws + WS_EWIN), M, 3072, D}; pg8::StaticOrder S; S.init(M, 3072, G, bx);
                pg8::EpiEvenIn E{EQ, (size_t)M * 512, (const float*)(ws + WS_ECOS), (const float*)(ws + WS_ESIN), QSCALE};
                pg8::gemm_phase<pg8::EpiEvenIn, pg8::StaticOrder, true, true>(ldsp, g, S, E); GRID_SYNC(); }
            if (IN(pb + 4)) {
#if NAIVE_ATTN
                attn_naive(EQ, EQ + (size_t)M * 512, EQ + (size_t)2 * M * 512, (bf16*)(ws + WS_EO), (LAS float*)(ldsp + wave * 8192), gw, NGW, opq(lane));
#endif
                GRID_SYNC(); }
            if (IN(pb + 5)) { post_attn((const bf16*)(ws + WS_EO), EQ + (size_t)3 * M * 512, EQ + (size_t)4 * M * 512, EQ + (size_t)5 * M * 512, (bf16*)(ws + WS_CAT), args.in[7], args.in[8], args.in[9], gw, NGW, opq(lane)); GRID_SYNC(); }
            if (IN(pb + 6)) { pg8::Gemm g{(const bf16*)(ws + WS_CAT), (const bf16*)(ws + WS_EWOUT), M, D, D}; pg8::StaticOrder S; S.init(M, D, G, bx);
                pg8::EpiResid E{out, out, ALPHA, 1.0f}; pg8::gemm_phase<pg8::EpiResid, pg8::StaticOrder, true, true>(ldsp, g, S, E); GRID_SYNC(); }
        } else {
            bf16* RQ = (bf16*)(ws + WS_RQ); bf16* RK = (bf16*)(ws + WS_RK); bf16* RV = (bf16*)(ws + WS_RV); bf16* RG = (bf16*)(ws + WS_RG);
#if NAIVE_RET
            bf16* Y = (bf16*)(ws + WS_YN);
#else
            bf16* Y = RV;
#endif
            if (IN(pb + 3)) { pg8::Gemm g{XB, (const bf16*)(ws + WS_OWIN), M, 6144, D}; pg8::StaticOrder S; S.init(M, 6144, G, bx);
                pg8::EpiOddIn E{RQ, RK, RV, RG, (const float*)(ws + WS_OCOS), (const float*)(ws + WS_OSIN)};
                pg8::gemm_phase<pg8::EpiOddIn, pg8::StaticOrder, true, true>(ldsp, g, S, E); GRID_SYNC(); }
            if (IN(pb + 4)) {
#if NAIVE_RET
                ret_naive(RQ, RK, RV, Y, (LAS float*)(ldsp + wave * 9216), (LAS float*)(ldsp + wave * 9216 + 1024), gw, NGW, opq(lane));
#endif
                GRID_SYNC(); }
            if (IN(pb + 5)) { post_ret(Y, RG, Y, args.in[12], gw, NGW, opq(lane)); GRID_SYNC(); }
            if (IN(pb + 6)) { pg8::Gemm g{Y, (const bf16*)(ws + WS_OWOUT), M, D, 2048}; pg8::StaticOrder S; S.init(M, D, G, bx);
                pg8::EpiResid E{out, out, ALPHA, 1.0f}; pg8::gemm_phase<pg8::EpiResid, pg8::StaticOrder, true, true>(ldsp, g, S, E); GRID_SYNC(); }
        }
        if (IN(pb + 7)) { for (int m = gw; m < M; m += NGW) ln_row(out + (size_t)m * D, out + (size_t)m * D, XB + (size_t)m * D, lng + 1 * D, lnb + 1 * D, opq(lane)); GRID_SYNC(); }
        FFN_STEP(1, 8, 2);
    }
#undef IN
}

extern "C" void kernel_launch(void* const* d_in, const int* in_sizes, int n_in, void* d_out, int out_size, void* d_ws, size_t ws_size, hipStream_t stream) {
    static int grid = 0;
    if (grid == 0) {
        if (n_in != 13 || out_size != M * D || ws_size < WS_END) { fprintf(stderr, "kernel_launch: unexpected problem (n_in %d, out %d, ws %zu)\n", n_in, out_size, ws_size); grid = -1; return; }
        int dev = 0, cus = 0, per_cu = 0;
        hipGetDevice(&dev); hipDeviceGetAttribute(&cus, hipDeviceAttributeMultiprocessorCount, dev);
#if MK_MULTI
        const void* kf = (const void*)mk_fwd<false>;
#else
        const void* kf = (const void*)mk_fwd<true>;
#endif
        if (hipFuncSetAttribute(kf, hipFuncAttributeMaxDynamicSharedMemorySize, LDS_BYTES) != hipSuccess) { fprintf(stderr, "kernel_launch: hipFuncSetAttribute failed\n"); grid = -1; return; }
        if (hipOccupancyMaxActiveBlocksPerMultiprocessor(&per_cu, kf, NWAVES * 64, LDS_BYTES) != hipSuccess || per_cu < 1) { fprintf(stderr, "kernel_launch: occupancy query says %d\n", per_cu); per_cu = 1; }
        (void)hipGetLastError();
        grid = cus * per_cu;
    }
    if (grid < 0) return;
    Args a{};
    for (int i = 0; i < 13; ++i) a.in[i] = (const float*)d_in[i];
    a.out = (float*)d_out; a.ws = (unsigned char*)d_ws;
#if MK_MULTI
    for (int ph = 0; ph < N_PHASES; ++ph) { a.ph_lo = ph; a.ph_hi = ph + 1; hipLaunchKernelGGL(mk_fwd<false>, dim3(grid), dim3(NWAVES * 64), LDS_BYTES, stream, a); }
#else
    a.ph_lo = 0; a.ph_hi = N_PHASES;
    void* kargs[] = {&a};
    hipError_t e = hipLaunchCooperativeKernel((const void*)mk_fwd<true>, dim3(grid), dim3(NWAVES * 64), kargs, LDS_BYTES, stream);
    if (e != hipSuccess) fprintf(stderr, "cooperative launch failed: %s (grid %d)\n", hipGetErrorString(e), grid);
#endif
}
```

```cpp
#include <hip/hip_runtime.h>
#include <hip/hip_cooperative_groups.h>
#include <cstdio>
#include <cstdint>
namespace cg = cooperative_groups;
namespace pg8 {
#define PG8_LAS __attribute__((address_space(3)))
typedef unsigned short bf16_t;
typedef short bf16x8 __attribute__((ext_vector_type(8)));
typedef float f32x4 __attribute__((ext_vector_type(4)));
typedef unsigned u32x4 __attribute__((ext_vector_type(4)));
constexpr int BM = 256, BK = 64, HALF = 128, HTB = HALF * BK * 2  , STAGE_BYTES = 8 * HTB, NXCD = 8, WGM = 8;

__host__ __device__ __forceinline__ int lds_byte(int r, int c) { const int st = (r >> 4) * 2 + (c >> 5), rr = r & 15, cc = c & 31, ob = rr * 64 + cc * 2; return st * 1024 + (ob ^ (((ob >> 9) & 1) << 5)); }
__host__ __device__ __forceinline__ void stage_rc(int b, int& R, int& C) { const int st = b / 1024, sb = b % 1024, swz = sb ^ (((sb >> 9) & 1) << 5); R = (st >> 1) * 16 + swz / 64; C = (st & 1) * 32 + (swz % 64) / 2; }
__host__ __device__ __forceinline__ int perm32(int rho) { const int n = rho >> 4, i = rho & 15; return 8 * (i >> 2) + 4 * n + (i & 3); }

struct Unit { int pm, pn; };
struct Gemm { const bf16_t* A; const bf16_t* Bt; int M, N, K; };

struct StaticOrder {
    int nM, nN, nwg, G, c;
    __host__ __device__ void init(int M, int N, int G_, int c_) { nM = M / BM; nN = N / BM; nwg = nM * nN; G = G_; c = c_; }
    __host__ __device__ bool next(int i, Unit& u) const {
        const long L = (long)i * G + c; if (L >= nwg) return false;
        int wgid = (int)L; { const int q = nwg / NXCD, r = nwg % NXCD, xcd = wgid % NXCD, off = wgid / NXCD; wgid = (xcd < r ? xcd * (q + 1) : r * (q + 1) + (xcd - r) * q) + off; }
        const int nig = WGM * nN, gid = wgid / nig, fm = gid * WGM, gsz = (nM - fm) < WGM ? (nM - fm) : WGM;
        u.pm = fm + ((wgid % nig) % gsz); u.pn = (wgid % nig) / gsz; return true;
    }
    __device__ __forceinline__ void a_ready(const Unit&) const {}
    __device__ __forceinline__ void done(const Unit&) const {}
};

__device__ __forceinline__ unsigned cvt_pk_bf16(float lo, float hi) { unsigned r; asm volatile("v_cvt_pk_bf16_f32 %0, %1, %2" : "=v"(r) : "v"(lo), "v"(hi)); return r; }
__device__ __forceinline__ float silu_f(float v) { return v * __builtin_amdgcn_rcpf(1.0f + __builtin_amdgcn_exp2f(-1.4426950408889634f * v)); }
__device__ __forceinline__ f32x4 silu4(f32x4 v) { return (f32x4){silu_f(v[0]), silu_f(v[1]), silu_f(v[2]), silu_f(v[3])}; }
__device__ __forceinline__ u32x4 pack8(f32x4 v0, f32x4 v1) { u32x4 w; w.x = cvt_pk_bf16(v0[0], v0[1]); w.y = cvt_pk_bf16(v0[2], v0[3]); w.z = cvt_pk_bf16(v1[0], v1[1]); w.w = cvt_pk_bf16(v1[2], v1[3]); return w; }

struct EpiSwiglu {
    static constexpr bool PERM = true, AFTER_DRAIN = false;
    bf16_t* H; int ldc;
    __device__ __forceinline__ void operator()(const f32x4 (&acc)[2][2][4][2], const Unit& u, int wr, int wc, int fr, int fq) const {
        const int row0 = u.pm * BM + wr * 64 + fr, col0 = u.pn * HALF + wc * 32 + 8 * fq;
#pragma unroll
        for (int ai = 0; ai < 2; ++ai)
#pragma unroll
            for (int m = 0; m < 4; ++m) { bf16_t* rowp = H + (size_t)(row0 + ai * HALF + m * 16) * ldc + col0;
                const f32x4 h0 = silu4(acc[ai][0][m][0]) * acc[ai][1][m][0], h1 = silu4(acc[ai][0][m][1]) * acc[ai][1][m][1];
                *(u32x4*)rowp = pack8(h0, h1); }
    }
};
struct EpiEvenIn {
    static constexpr bool PERM = true, AFTER_DRAIN = false;
    bf16_t* base; size_t seg_stride; const float* cosT; const float* sinT; float qscale;
    __device__ __forceinline__ void operator()(const f32x4 (&acc)[2][2][4][2], const Unit& u, int wr, int wc, int fr, int fq) const {
        const int t = u.pn >> 1, colseg = (u.pn & 1) * 256 + wc * 32 + 8 * fq, row0 = u.pm * BM + wr * 64 + fr;
        bf16_t* ob = base + (size_t)t * seg_stride;
        const bool rot = (t < 2) && ((wc & 1) == 0) && (fq < 2);
        const float sc = (t == 0) ? qscale : 1.0f;
#pragma unroll
        for (int ai = 0; ai < 2; ++ai)
#pragma unroll
            for (int m = 0; m < 4; ++m) { const int row = row0 + ai * HALF + m * 16, pos = row & 2047;
                f32x4 cs = (f32x4){1.f, 1.f, 1.f, 1.f}, sn = (f32x4){0.f, 0.f, 0.f, 0.f};
                if (rot) { cs = *(const f32x4*)(cosT + pos * 8 + 4 * fq); sn = *(const f32x4*)(sinT + pos * 8 + 4 * fq); }
#pragma unroll
                for (int bj = 0; bj < 2; ++bj) { const f32x4 x1 = acc[ai][bj][m][0], x2 = acc[ai][bj][m][1];
                    const f32x4 y1 = (x1 * cs - x2 * sn) * sc, y2 = (x2 * cs + x1 * sn) * sc;
                    *(u32x4*)(ob + (size_t)row * 512 + colseg + bj * HALF) = pack8(y1, y2); } }
    }
};
struct EpiOddIn {
    static constexpr bool PERM = true, AFTER_DRAIN = false;
    bf16_t *RQ, *RK, *RV, *RG; const float* cosT; const float* sinT;
    __device__ __forceinline__ void operator()(const f32x4 (&acc)[2][2][4][2], const Unit& u, int wr, int wc, int fr, int fq) const {
        const int pn = u.pn, d0 = wc * 32 + 8 * fq, row0 = u.pm * BM + wr * 64 + fr;
        if (pn < 8) {
            bf16_t* ob = (pn < 4) ? RQ : RK; const int hcol = (pn & 3) * 256 + d0; const float sc = (pn < 4) ? 1.0f : 0.0625f;
#pragma unroll
            for (int ai = 0; ai < 2; ++ai)
#pragma unroll
                for (int m = 0; m < 4; ++m) { const int row = row0 + ai * HALF + m * 16, pos = row & 2047;
                    f32x4 y1[2], y2[2];
#pragma unroll
                    for (int n = 0; n < 2; ++n) { const f32x4 cs = *(const f32x4*)(cosT + pos * 128 + d0 + 4 * n), sn = *(const f32x4*)(sinT + pos * 128 + d0 + 4 * n);
                        const f32x4 x1 = acc[ai][0][m][n], x2 = acc[ai][1][m][n];
                        y1[n] = (x1 * cs - x2 * sn) * sc; y2[n] = (x2 * cs + x1 * sn) * sc; }
                    *(u32x4*)(ob + (size_t)row * 1024 + hcol) = pack8(y1[0], y1[1]);
                    *(u32x4*)(ob + (size_t)row * 1024 + hcol + HALF) = pack8(y2[0], y2[1]); }
        } else {
            bf16_t* ob = (pn < 16) ? RV : RG; const int colt = (pn & 7) * 256 + d0; const bool act = pn >= 16;
#pragma unroll
            for (int ai = 0; ai < 2; ++ai)
#pragma unroll
                for (int m = 0; m < 4; ++m) { const int row = row0 + ai * HALF + m * 16;
#pragma unroll
                    for (int bj = 0; bj < 2; ++bj) { f32x4 v0 = acc[ai][bj][m][0], v1 = acc[ai][bj][m][1];
                        if (act) { v0 = silu4(v0); v1 = silu4(v1); }
                        *(u32x4*)(ob + (size_t)row * 2048 + colt + bj * HALF) = pack8(v0, v1); } }
        }
    }
};
struct EpiResid {
    static constexpr bool PERM = false, AFTER_DRAIN = false;
    const float* base; float* out; float a, s;
    __device__ __forceinline__ void operator()(const f32x4 (&acc)[2][2][4][2], const Unit& u, int wr, int wc, int fr, int fq) const {
        const int col0 = u.pn * BM + wc * 32 + 4 * fq, row0 = u.pm * BM + wr * 64 + fr;
#pragma unroll
        for (int ai = 0; ai < 2; ++ai)
#pragma unroll
            for (int m = 0; m < 4; ++m) { const size_t off = (size_t)(row0 + ai * HALF + m * 16) * 1024 + col0;
#pragma unroll
                for (int bj = 0; bj < 2; ++bj)
#pragma unroll
                    for (int n = 0; n < 2; ++n) { const f32x4 b = *(const f32x4*)(base + off + bj * HALF + n * 16);
                        *(f32x4*)(out + off + bj * HALF + n * 16) = b * a + acc[ai][bj][m][n] * s; } }
    }
};

template <class Epi, class Sched, bool ALIGN_EPI = false, bool SP2 = false>
__device__ __forceinline__ void gemm_phase(PG8_LAS unsigned char* lds, const Gemm g, const Sched& S, const Epi& E) {
    int tid_ = threadIdx.x; asm volatile("" : "+v"(tid_));
    const int tid = tid_, wid = __builtin_amdgcn_readfirstlane(tid >> 6), lane = tid & 63, wr = wid >> 2, wc = wid & 3, fr = lane & 15, fq = lane >> 4;
    const int K = g.K, nt = K / BK;
    unsigned voffA[2], voffB[2];
#pragma unroll
    for (int i = 0; i < 2; ++i) { int R, C; stage_rc(tid * 16 + i * 8192, R, C); const int Rb = Epi::PERM ? ((R & ~31) + perm32(R & 31)) : R;
        voffA[i] = (unsigned)(R * K + C) * 2u; voffB[i] = (unsigned)(Rb * K + C) * 2u; }
    const size_t kstep = (size_t)(BK * 2);
    const size_t hstep = (size_t)HALF * K * 2;
    const size_t tstep = 2 * hstep;
    const unsigned ldsw = (unsigned)wid * 1024u;
    const int aoff = lds_byte(wr * 64 + fr, fq * 8), boff = lds_byte(wc * 32 + fr, fq * 8);
#define PG8_SA(b, h) (((b) * 2 + (h)) * HTB)
#define PG8_SB(b, h) ((4 + (b) * 2 + (h)) * HTB)
#define PG8_STAGE(bufoff, gbase, voff) do { _Pragma("unroll") for (int _i = 0; _i < 2; ++_i) \
        __builtin_amdgcn_global_load_lds((const unsigned*)((const char*)(gbase) + (voff)[_i]), (PG8_LAS unsigned*)(lds + (bufoff) + ldsw + _i * 8192), 16, 0, 0); } while (0)
#define PG8_LDA(dst, b, h) do { _Pragma("unroll") for (int m = 0; m < 4; ++m) _Pragma("unroll") for (int k = 0; k < 2; ++k) dst[m][k] = *(const PG8_LAS bf16x8*)(lds + PG8_SA(b, h) + aoff + m * 2048 + k * 1024); } while (0)
#define PG8_LDB(dst, b, h) do { _Pragma("unroll") for (int n = 0; n < 2; ++n) _Pragma("unroll") for (int k = 0; k < 2; ++k) dst[n][k] = *(const PG8_LAS bf16x8*)(lds + PG8_SB(b, h) + boff + n * 2048 + k * 1024); } while (0)
#define PG8_MMA(ai, bj, At, Bt) do { __builtin_amdgcn_s_setprio(1); _Pragma("unroll") for (int m = 0; m < 4; ++m) _Pragma("unroll") for (int n = 0; n < 2; ++n) _Pragma("unroll") for (int k = 0; k < 2; ++k) \
        acc[ai][bj][m][n] = __builtin_amdgcn_mfma_f32_16x16x32_bf16(Bt[n][k], At[m][k], acc[ai][bj][m][n], 0, 0, 0); __builtin_amdgcn_s_setprio(0); } while (0)
#define PG8_WAIT_V(n) asm volatile("s_waitcnt vmcnt(" #n ")" ::: "memory")
#define PG8_WAIT_L(n) asm volatile("s_waitcnt lgkmcnt(" #n ")" ::: "memory")
#define PG8_BAR __builtin_amdgcn_s_barrier()
#define PG8_SCHED __builtin_amdgcn_sched_barrier(0)
    Unit cur, nxt; int ui = 0;
    if (!S.next(0, cur)) return;
    f32x4 acc[2][2][4][2];
#pragma unroll
    for (int a = 0; a < 2; ++a)
#pragma unroll
        for (int b = 0; b < 2; ++b)
#pragma unroll
            for (int m = 0; m < 4; ++m)
#pragma unroll
                for (int n = 0; n < 2; ++n) acc[a][b][m][n] = (f32x4){0.f, 0.f, 0.f, 0.f};
    bf16x8 At[4][2], B0[2][2], B1[2][2];
    const char* cA = (const char*)g.A + (size_t)cur.pm * tstep; const char* cB = (const char*)g.Bt + (size_t)cur.pn * tstep;
    S.a_ready(cur);
    if constexpr (SP2) {
        PG8_STAGE(PG8_SB(0, 0), cB, voffB); PG8_STAGE(PG8_SB(0, 1), cB + hstep, voffB); PG8_STAGE(PG8_SA(0, 0), cA, voffA); PG8_STAGE(PG8_SA(0, 1), cA + hstep, voffA);
        if (wr == 1) PG8_BAR;
        PG8_WAIT_V(2); PG8_BAR;
        PG8_STAGE(PG8_SB(1, 0), cB + kstep, voffB); PG8_STAGE(PG8_SA(1, 0), cA + kstep, voffA); PG8_STAGE(PG8_SB(1, 1), cB + hstep + kstep, voffB);
        PG8_WAIT_V(6); PG8_BAR;
    } else {
        PG8_STAGE(PG8_SB(0, 0), cB, voffB); PG8_STAGE(PG8_SA(0, 0), cA, voffA); PG8_STAGE(PG8_SB(0, 1), cB + hstep, voffB); PG8_STAGE(PG8_SA(0, 1), cA + hstep, voffA);
        if (wr == 1) PG8_BAR;
        PG8_WAIT_V(4); PG8_BAR;
        PG8_STAGE(PG8_SB(1, 0), cB + kstep, voffB); PG8_STAGE(PG8_SA(1, 0), cA + kstep, voffA); PG8_STAGE(PG8_SB(1, 1), cB + hstep + kstep, voffB);
        PG8_WAIT_V(6); PG8_BAR;
    }
    for (;;) {
        const bool has_next = S.next(ui + 1, nxt);
        const char* nA = has_next ? (const char*)g.A + (size_t)nxt.pm * tstep : cA; const char* nB = has_next ? (const char*)g.Bt + (size_t)nxt.pn * tstep : cB;
        for (int t = 0; t < nt; t += 2) {
            const bool last = (t == nt - 2);
            const char* a1 = cA + (size_t)(t + 1) * kstep;
            const char* a2 = last ? nA : cA + (size_t)(t + 2) * kstep; const char* b2 = last ? nB : cB + (size_t)(t + 2) * kstep;
            const char* a3 = a2 + kstep; const char* b3 = b2 + kstep;
            if (last && has_next) S.a_ready(nxt);
            if constexpr (SP2) {
            PG8_LDB(B0, 0, 0); PG8_LDB(B1, 0, 1); PG8_SCHED; PG8_LDA(At, 0, 0); PG8_STAGE(PG8_SA(1, 1), a1 + hstep, voffA);
            PG8_WAIT_V(8); PG8_WAIT_L(0); PG8_BAR; PG8_MMA(0, 0, At, B0); PG8_MMA(0, 1, At, B1); PG8_BAR; PG8_SCHED;
            PG8_LDA(At, 0, 1); PG8_STAGE(PG8_SB(0, 0), b2, voffB); PG8_STAGE(PG8_SB(0, 1), b2 + hstep, voffB); PG8_STAGE(PG8_SA(0, 0), a2, voffA);
            PG8_WAIT_V(8); PG8_WAIT_L(0); PG8_BAR; PG8_MMA(1, 0, At, B0); PG8_MMA(1, 1, At, B1); PG8_BAR; PG8_SCHED;
            PG8_LDB(B0, 1, 0); PG8_LDB(B1, 1, 1); PG8_SCHED; PG8_LDA(At, 1, 0); PG8_STAGE(PG8_SA(0, 1), a2 + hstep, voffA);
            PG8_WAIT_V(8); PG8_WAIT_L(0); PG8_BAR; PG8_MMA(0, 0, At, B0); PG8_MMA(0, 1, At, B1); PG8_BAR; PG8_SCHED;
            PG8_LDA(At, 1, 1); PG8_STAGE(PG8_SB(1, 0), b3, voffB); PG8_STAGE(PG8_SB(1, 1), b3 + hstep, voffB); PG8_STAGE(PG8_SA(1, 0), a3, voffA);
            PG8_WAIT_V(8); PG8_WAIT_L(0); PG8_BAR; PG8_MMA(1, 0, At, B0); PG8_MMA(1, 1, At, B1); PG8_BAR; PG8_SCHED;
            } else {
            PG8_LDB(B0, 0, 0); PG8_SCHED; PG8_LDA(At, 0, 0); PG8_STAGE(PG8_SA(1, 1), a1 + hstep, voffA);
            PG8_WAIT_L(8); PG8_BAR; PG8_WAIT_L(0); PG8_MMA(0, 0, At, B0); PG8_BAR; PG8_SCHED;
            PG8_LDB(B1, 0, 1); PG8_STAGE(PG8_SB(0, 0), b2, voffB);
            PG8_BAR; PG8_WAIT_L(0); PG8_MMA(0, 1, At, B1); PG8_BAR;
            PG8_LDA(At, 0, 1); PG8_STAGE(PG8_SA(0, 0), a2, voffA);
            PG8_BAR; PG8_WAIT_L(0); PG8_MMA(1, 0, At, B0); PG8_BAR; PG8_SCHED;
            PG8_STAGE(PG8_SB(0, 1), b2 + hstep, voffB);
            PG8_WAIT_V(6); PG8_BAR; PG8_MMA(1, 1, At, B1); PG8_BAR;
            PG8_LDB(B0, 1, 0); PG8_SCHED; PG8_LDA(At, 1, 0); PG8_STAGE(PG8_SA(0, 1), a2 + hstep, voffA);
            PG8_WAIT_L(8); PG8_BAR; PG8_WAIT_L(0); PG8_MMA(0, 0, At, B0); PG8_BAR; PG8_SCHED;
            PG8_LDB(B1, 1, 1); PG8_STAGE(PG8_SB(1, 0), b3, voffB);
            PG8_BAR; PG8_WAIT_L(0); PG8_MMA(0, 1, At, B1); PG8_BAR;
            PG8_LDA(At, 1, 1); PG8_STAGE(PG8_SA(1, 0), a3, voffA);
            PG8_BAR; PG8_WAIT_L(0); PG8_MMA(1, 0, At, B0); PG8_BAR; PG8_SCHED;
            PG8_STAGE(PG8_SB(1, 1), b3 + hstep, voffB);
            PG8_WAIT_V(6); PG8_BAR; PG8_MMA(1, 1, At, B1); PG8_BAR;
            }
        }
        if constexpr (ALIGN_EPI) { if (wr == 0) PG8_BAR; }
        if constexpr (!Epi::AFTER_DRAIN) { E(acc, cur, wr, wc, fr, fq); S.done(cur); }
        if (!has_next) break;
#pragma unroll
        for (int a = 0; a < 2; ++a)
#pragma unroll
            for (int b = 0; b < 2; ++b)
#pragma unroll
                for (int m = 0; m < 4; ++m)
#pragma unroll
                    for (int n = 0; n < 2; ++n) acc[a][b][m][n] = (f32x4){0.f, 0.f, 0.f, 0.f};
        cur = nxt; cA = nA; cB = nB; ++ui;
        if constexpr (ALIGN_EPI) { if (wr == 1) PG8_BAR; }
    }
    PG8_WAIT_V(0);
    if constexpr (!ALIGN_EPI) { if (wr == 0) PG8_BAR; }
    PG8_BAR;
    if constexpr (Epi::AFTER_DRAIN) { E.fused(acc, cur, wr, wc, fr, fq, lds, wid, lane); S.done(cur); }
#undef PG8_SA
#undef PG8_SB
#undef PG8_STAGE
#undef PG8_LDA
#undef PG8_LDB
#undef PG8_MMA
#undef PG8_WAIT_V
#undef PG8_WAIT_L
#undef PG8_BAR
#undef PG8_SCHED
}
}
#include <hip/hip_bf16.h>
#include <cmath>
namespace attn_body {
using bf16=__hip_bfloat16;
using bf16x8=__attribute__((ext_vector_type(8)))short;
using s16x4=__attribute__((ext_vector_type(4)))short;
using f32x16=__attribute__((ext_vector_type(16)))float;
using u32x4=__attribute__((ext_vector_type(4)))unsigned;
constexpr int BATCH=8,NHEAD=16,SEQ=2048,D=64;
constexpr int QP=512,KP=512,VP=512,OP=1024;
constexpr int NW=8,QBLK=32,QB=QBLK*NW,KVBLK=64,NQB=SEQ/QB;
constexpr int ATTN_UNIT_ROWS=QB;
__device__ __forceinline__ int crow(int r,int hi){return (r&3)+8*(r>>2)+4*hi;}
#define SBAR() __builtin_amdgcn_sched_barrier(0)
__device__ __forceinline__ void cmask(f32x16&p0,f32x16&p1,int jb,int qrel,int hi){
  const float NEG=-INFINITY; int kb=64*jb+4*hi;
  #pragma unroll
  for(int r=0;r<16;++r){int kv=kb+(r&3)+8*(r>>2); if(kv>qrel)p0[r]=NEG; if(kv+32>qrel)p1[r]=NEG;}
}

constexpr int NSLOT=3, SLOTB=8192;
constexpr int LDS_K=0, LDS_V=NSLOT*SLOTB, LDS_WS=2*NSLOT*SLOTB, LDS_OST=LDS_WS+NW*64*4, LDS_BYTES=LDS_OST+NW*4096;
constexpr float C2=0.125f*1.4426950408889634f;
__device__ __forceinline__ void glds16(const void*gsrc,unsigned lds_dst){unsigned keep;
  asm volatile("s_mov_b32 %0, m0\n\ts_mov_b32 m0, %2\n\ts_nop 0\n\tglobal_load_lds_dwordx4 %1, off\n\ts_mov_b32 m0, %0":"=&s"(keep):"v"(gsrc),"s"(lds_dst):"memory");}
__device__ __forceinline__ float max3f(float a,float b,float c){float r;asm("v_max3_f32 %0, %1, %2, %3":"=v"(r):"v"(a),"v"(b),"v"(c));return r;}
__device__ __forceinline__ float max2f(float a,float b){float r;asm("v_max_f32_e32 %0, %1, %2":"=v"(r):"v"(a),"v"(b));return r;}
__device__ __forceinline__ float fadd_s(float a,float b){float r;asm("v_add_f32_e32 %0, %1, %2":"=v"(r):"v"(a),"v"(b));return r;}
__device__ __forceinline__ float fsub_s(float a,float b){float r;asm("v_sub_f32_e32 %0, %1, %2":"=v"(r):"v"(a),"v"(b));return r;}
typedef float f32x2_t __attribute__((ext_vector_type(2))); typedef __bf16 bf16x2_t __attribute__((ext_vector_type(2)));
__device__ __forceinline__ unsigned cvtpk_s(float lo,float hi){f32x2_t v={lo,hi};bf16x2_t b=__builtin_convertvector(v,bf16x2_t);return __builtin_bit_cast(unsigned,b);}
#define WAIT_BAR(N) asm volatile("s_waitcnt vmcnt(" #N ") lgkmcnt(0)\n\ts_barrier":::"memory")

__device__ __forceinline__ void qkt(f32x16&p0,f32x16&p1,const char*Kslot,const bf16x8*qr,const f32x16&negm,int r32,int hi){
  const char*kb=Kslot+hi*1024+r32*16;
  #pragma unroll
  for(int d0=0;d0<4;++d0){
    const bf16x8 b0=*reinterpret_cast<const bf16x8*>(kb+d0*2048);
    const bf16x8 b1=*reinterpret_cast<const bf16x8*>(kb+d0*2048+512);
    if(d0==0){p0=__builtin_amdgcn_mfma_f32_32x32x16_bf16(b0,qr[0],negm,0,0,0);p1=__builtin_amdgcn_mfma_f32_32x32x16_bf16(b1,qr[0],negm,0,0,0);}
    else{p0=__builtin_amdgcn_mfma_f32_32x32x16_bf16(b0,qr[d0],p0,0,0,0);p1=__builtin_amdgcn_mfma_f32_32x32x16_bf16(b1,qr[d0],p1,0,0,0);}}
}
typedef __attribute__((address_space(3))) const char* lds_cptr;
typedef short v4i16_t __attribute__((ext_vector_type(4)));
__device__ __forceinline__ void kload8(bf16x8*kf,lds_cptr kp){
  kf[0]=*(const __attribute__((address_space(3))) bf16x8*)(kp);      kf[1]=*(const __attribute__((address_space(3))) bf16x8*)(kp+512);
  kf[2]=*(const __attribute__((address_space(3))) bf16x8*)(kp+2048); kf[3]=*(const __attribute__((address_space(3))) bf16x8*)(kp+2560);
  kf[4]=*(const __attribute__((address_space(3))) bf16x8*)(kp+4096); kf[5]=*(const __attribute__((address_space(3))) bf16x8*)(kp+4608);
  kf[6]=*(const __attribute__((address_space(3))) bf16x8*)(kp+6144); kf[7]=*(const __attribute__((address_space(3))) bf16x8*)(kp+6656);
}
__device__ __forceinline__ void kload2(bf16x8*kf,lds_cptr kp,int j){ kf[2*j]=*(const __attribute__((address_space(3))) bf16x8*)(kp+j*2048); kf[2*j+1]=*(const __attribute__((address_space(3))) bf16x8*)(kp+j*2048+512); }
__device__ __forceinline__ s16x4 vtr(lds_cptr p){ return __builtin_bit_cast(s16x4,__builtin_amdgcn_ds_read_tr16_b64_v4i16((__attribute__((address_space(3))) v4i16_t*)p)); }
__device__ __forceinline__ float rowmax(const f32x16&p0,const f32x16&p1){
  float a=max3f(p0[0],p0[1],p1[0]),b=max3f(p0[2],p0[3],p1[1]);a=max3f(a,p1[2],p1[3]);
  #pragma unroll
  for(int r=4;r<16;r+=4){a=max3f(a,p0[r],p0[r+1]);b=max3f(b,p0[r+2],p0[r+3]);a=max3f(a,p1[r],p1[r+1]);b=max3f(b,p1[r+2],p1[r+3]);}
  const float m=max2f(a,b);
  auto rr=__builtin_amdgcn_permlane32_swap(__float_as_uint(m),__float_as_uint(m),false,false);
  return max2f(__uint_as_float(rr[0]),__uint_as_float(rr[1]));
}
__device__ __forceinline__ void pv(f32x16*o,int vb,bf16x8 pa0,bf16x8 pa1,bf16x8 pa2,bf16x8 pa3){
  #pragma unroll
  for(int d0=0;d0<2;++d0){s16x4 lo[4],hi[4];
    #pragma unroll
    for(int ks=0;ks<4;++ks){
      asm volatile("ds_read_b64_tr_b16 %0,%1 offset:%c2":"=&v"(lo[ks]):"v"(vb),"i"(d0*4096+ks*1024):"memory");
      asm volatile("ds_read_b64_tr_b16 %0,%1 offset:%c2":"=&v"(hi[ks]):"v"(vb),"i"(d0*4096+ks*1024+512):"memory");}
    asm volatile("s_waitcnt lgkmcnt(0)":::"memory");SBAR();
    #define PK(k) (bf16x8){lo[k][0],lo[k][1],lo[k][2],lo[k][3],hi[k][0],hi[k][1],hi[k][2],hi[k][3]}
    o[d0]=__builtin_amdgcn_mfma_f32_32x32x16_bf16(pa0,PK(0),o[d0],0,0,0);
    o[d0]=__builtin_amdgcn_mfma_f32_32x32x16_bf16(pa1,PK(1),o[d0],0,0,0);
    o[d0]=__builtin_amdgcn_mfma_f32_32x32x16_bf16(pa2,PK(2),o[d0],0,0,0);
    o[d0]=__builtin_amdgcn_mfma_f32_32x32x16_bf16(pa3,PK(3),o[d0],0,0,0);
    #undef PK
  }
}

#ifndef ATTN_STORE16
#define ATTN_STORE16(p,v) (*(u32x4*)(p)=(v))
#endif
template<int THRL> __device__ __forceinline__ void attn_unit(int b,int h,int qb,const bf16*Q,const bf16*__restrict__ K,const bf16*__restrict__ V,bf16*O,char*shm){
  int tid_=threadIdx.x; asm volatile("":"+v"(tid_)); const int tid=tid_,lane=tid&63,r32=lane&31,hi=lane>>5; const int wid=__builtin_amdgcn_readfirstlane(tid>>6);
  const long rowbase=(long)b*SEQ; const int q0=qb*QB;
  const int hc=h>>1;
  const bf16*Qw=Q+(rowbase+q0+wid*QBLK)*QP+hc*D;
  const bf16*Kh=K+rowbase*KP+hc*D,*Vh=V+rowbase*VP+(hc>>1)*128+(h&1)*64;
  const unsigned lds0=(unsigned)(uintptr_t)shm;
  float*wsf=(float*)(shm+LDS_WS)+wid*64;
  const bf16*ksrc=Kh+(long)lane*KP+wid*8;
  const bf16*vsrc=Vh+(long)(16*(wid&3)+(lane>>2))*VP+(wid>>2)*32+(lane&3)*8;
  const unsigned kdst=lds0+LDS_K+wid*1024, vdst=lds0+LDS_V+wid*1024;
  #define DMA_K(t,slot) glds16(ksrc+(long)(t)*KVBLK*KP,(unsigned)__builtin_amdgcn_readfirstlane(kdst+(slot)))
  #define DMA_V(t,slot) glds16(vsrc+(long)(t)*KVBLK*VP,(unsigned)__builtin_amdgcn_readfirstlane(vdst+(slot)))
  const int vb0=(int)(lds0+LDS_V)+((lane>>4)&1)*32+(lane&3)*8+(4*hi+((lane&15)>>2))*64;
  const char*Kbase=shm+LDS_K; bf16x8 kf[8];
  const lds_cptr shm3=(lds_cptr)shm; const lds_cptr kp0=shm3+LDS_K+hi*1024+r32*16; const lds_cptr vp0=shm3+LDS_V+((lane>>4)&1)*32+(lane&3)*8+(4*hi+((lane&15)>>2))*64;
  const int NT=(q0+QB)/KVBLK;
  DMA_K(0,0);DMA_V(0,0);DMA_K(1,SLOTB);
  bf16x8 qr[4];
  #pragma unroll
  for(int d0=0;d0<4;++d0)qr[d0]=*reinterpret_cast<const bf16x8*>(&Qw[(long)r32*QP+d0*16+hi*8]);
  float mhat=0.f,l_reg=0.f;f32x16 o[2];o[0]=f32x16{};o[1]=f32x16{};f32x16 negm=f32x16{};asm volatile("":"+v"(negm));
  const int qrel=wid*QBLK+r32;
  #define CMASK(P0,P1,t) do{int jb_=(t)-(NT-4); if(jb_>=0)cmask(P0,P1,jb_,qrel,hi);}while(0)
  bool resc=false;
  #define START(P0,P1) do{ const float rm=rowmax(P0,P1); resc=false; \
    { const float dl=rm; mhat=fadd_s(mhat,dl); \
      _Pragma("unroll") for(int r=0;r<16;++r){P0[r]=fsub_s(P0[r],dl);P1[r]=fsub_s(P1[r],dl);} \
      _Pragma("unroll") for(int r=0;r<16;++r)negm[r]=-mhat; asm volatile("":"+v"(negm)); } \
    _Pragma("unroll") for(int r=0;r<16;++r)P0[r]=__builtin_amdgcn_exp2f(P0[r]); }while(0)
  #define RESC() do{ if(resc){ asm volatile("s_waitcnt lgkmcnt(0)":::"memory"); \
      _Pragma("unroll") for(int d_=0;d_<2;++d_) _Pragma("unroll") for(int r=0;r<16;++r)o[d_][r]*=wsf[crow(r,hi)]; } }while(0)
  f32x16 pA0,pA1,pB0,pB1;
  int sl_prev=0,sl_cur=0,sl_next=SLOTB;
  #define ROT() do{sl_prev=sl_cur;sl_cur=sl_next;sl_next=(sl_next==(NSLOT-1)*SLOTB)?0:sl_next+SLOTB;}while(0)
  DMA_K(2,2*SLOTB);
  WAIT_BAR(3);
  qkt(pA0,pA1,Kbase,qr,negm,r32,hi);asm volatile("s_nop 15\n\ts_nop 7":"+v"(pA0),"+v"(pA1));CMASK(pA0,pA1,0);
  START(pA0,pA1);
  _Pragma("unroll") for(int r=0;r<16;++r)pA1[r]=__builtin_amdgcn_exp2f(pA1[r]);
  WAIT_BAR(0);
  DMA_K(3,0);DMA_V(1,SLOTB);
  ROT();
  kload8(kf,kp0+sl_cur);
  WAIT_BAR(2);
  s16x4 vlo[8],vhi[8]; u32x4 pw0,pw1,pw2,pw3;
  #define PKW(P,B) cvtpk_s(P[B],P[B+1])
  #define PAF(k) __builtin_bit_cast(bf16x8,pw##k)
  #define VFR(i) (bf16x8){vlo[i][0],vlo[i][1],vlo[i][2],vlo[i][3],vhi[i][0],vhi[i][1],vhi[i][2],vhi[i][3]}
  #define PIN(x) asm volatile("":"+v"(x))
  #define MX3(a,b,c) __builtin_fmaxf(__builtin_fmaxf((a),(b)),(c))
  #define GAPA(MF,A0,A1,A2,A3,W0,W1,PW) do{ MF; sacc+=A0; sacc+=A1; sacc+=A2; sacc+=A3; PIN(sacc); W0; W1; PIN(PW); SBAR(); }while(0)
  #define EX(v) __builtin_amdgcn_exp2f(v)
  #define GAPB(MF,X,B) do{ MF; X[B]=EX(X[B]); X[B+1]=EX(X[B+1]); X[B+2]=EX(X[B+2]); X[B+3]=EX(X[B+3]); PIN(X); SBAR(); }while(0)
  #define VRD(i) do{ vlo[i]=vtr(vp_+(((i)>>2)*4096+((i)&3)*1024)); vhi[i]=vtr(vp_+(((i)>>2)*4096+((i)&3)*1024+512)); }while(0)
  #define KRD(G,j) do{ if(G){ kload2(kf,kp0+sl_next,j); SBAR(); } }while(0)
  #define STEP(C0,C1,P0,P1,t,GK,GV,GL) do{ SBAR(); \
    const lds_cptr vp_=vp0+sl_prev; \
    VRD(0); SBAR(); float sacc=(P0[0]+P0[1]); \
    GAPA(C0=__builtin_amdgcn_mfma_f32_32x32x16_bf16(kf[0],qr[0],negm,0,0,0), P0[2],P0[3],P0[4],P0[5],     pw0[0]=PKW(P0,0), pw0[1]=PKW(P0,2), pw0); \
    VRD(4); SBAR(); GAPA(C1=__builtin_amdgcn_mfma_f32_32x32x16_bf16(kf[1],qr[0],negm,0,0,0), P0[6],P0[7],P0[8],P0[9],     pw0[2]=PKW(P0,4), pw0[3]=PKW(P0,6), pw0); \
    VRD(1); SBAR(); GAPA(C0=__builtin_amdgcn_mfma_f32_32x32x16_bf16(kf[2],qr[1],C0,0,0,0),   P0[10],P0[11],P0[12],P0[13], pw1[0]=PKW(P0,8), pw1[1]=PKW(P0,10), pw1); \
    VRD(5); SBAR(); GAPA(C1=__builtin_amdgcn_mfma_f32_32x32x16_bf16(kf[3],qr[1],C1,0,0,0),   P0[14],P0[15],P1[0],P1[1],   pw1[2]=PKW(P0,12),pw1[3]=PKW(P0,14), pw1); \
    VRD(2); SBAR(); GAPA(C0=__builtin_amdgcn_mfma_f32_32x32x16_bf16(kf[4],qr[2],C0,0,0,0),   P1[2],P1[3],P1[4],P1[5],     pw2[0]=PKW(P1,0), pw2[1]=PKW(P1,2), pw2); \
    VRD(6); SBAR(); GAPA(C1=__builtin_amdgcn_mfma_f32_32x32x16_bf16(kf[5],qr[2],C1,0,0,0),   P1[6],P1[7],P1[8],P1[9],     pw2[2]=PKW(P1,4), pw2[3]=PKW(P1,6), pw2); \
    VRD(3); SBAR(); GAPA(C0=__builtin_amdgcn_mfma_f32_32x32x16_bf16(kf[6],qr[3],C0,0,0,0),   P1[10],P1[11],P1[12],P1[13], pw3[0]=PKW(P1,8), pw3[1]=PKW(P1,10), pw3); \
    VRD(7); SBAR(); GAPA(C1=__builtin_amdgcn_mfma_f32_32x32x16_bf16(kf[7],qr[3],C1,0,0,0),   P1[14],P1[15],0.f,0.f,       pw3[2]=PKW(P1,12),pw3[3]=PKW(P1,14), pw3); \
    l_reg+=sacc; \
    if(GK){DMA_K((t)+3,sl_cur);} if(GV){DMA_V((t)+1,sl_next);} \
    CMASK(C0,C1,t); \
    { float a=MX3(C0[0],C0[1],C1[0]),b=MX3(C0[2],C0[3],C1[1]); a=MX3(a,C1[2],C1[3]); \
      _Pragma("unroll") for(int r=4;r<16;r+=4){a=MX3(a,C0[r],C0[r+1]);b=MX3(b,C0[r+2],C0[r+3]);a=MX3(a,C1[r],C1[r+1]);b=MX3(b,C1[r+2],C1[r+3]);} \
      float rm=__builtin_fmaxf(a,b); { auto rr=__builtin_amdgcn_permlane32_swap(__float_as_uint(rm),__float_as_uint(rm),false,false); rm=__builtin_fmaxf(__uint_as_float(rr[0]),__uint_as_float(rr[1])); } \
      resc=false; \
      if(__builtin_expect(__any(rm>(float)THRL),0)){ const float dl=__builtin_fmaxf(rm,0.f); mhat+=dl; \
        _Pragma("unroll") for(int r=0;r<16;++r){C0[r]-=dl;C1[r]-=dl;} \
        _Pragma("unroll") for(int r=0;r<16;++r)negm[r]=-mhat; asm volatile("":"+v"(negm)); \
        const float f=__builtin_amdgcn_exp2f(-dl); l_reg*=f; if(hi==0)wsf[r32]=f; resc=true; } } \
    SBAR(); \
    GAPB(o[0]=__builtin_amdgcn_mfma_f32_32x32x16_bf16(PAF(0),VFR(0),o[0],0,0,0), C0,0); \
    GAPB(o[1]=__builtin_amdgcn_mfma_f32_32x32x16_bf16(PAF(0),VFR(4),o[1],0,0,0), C0,4); \
    KRD(GL,0); GAPB(o[0]=__builtin_amdgcn_mfma_f32_32x32x16_bf16(PAF(1),VFR(1),o[0],0,0,0), C0,8); \
    KRD(GL,1); GAPB(o[1]=__builtin_amdgcn_mfma_f32_32x32x16_bf16(PAF(1),VFR(5),o[1],0,0,0), C0,12); \
    KRD(GL,2); GAPB(o[0]=__builtin_amdgcn_mfma_f32_32x32x16_bf16(PAF(2),VFR(2),o[0],0,0,0), C1,0); \
    KRD(GL,3); GAPB(o[1]=__builtin_amdgcn_mfma_f32_32x32x16_bf16(PAF(2),VFR(6),o[1],0,0,0), C1,4); \
    GAPB(o[0]=__builtin_amdgcn_mfma_f32_32x32x16_bf16(PAF(3),VFR(3),o[0],0,0,0), C1,8); \
    GAPB(o[1]=__builtin_amdgcn_mfma_f32_32x32x16_bf16(PAF(3),VFR(7),o[1],0,0,0), C1,12); \
    }while(0)
  int t=1;
  #undef CMASK
  #define CMASK(P0,P1,t) do{}while(0)
  for(;t+5<NT;t+=2){
    STEP(pB0,pB1,pA0,pA1,t,true,true,true);     WAIT_BAR(2); RESC(); ROT();
    STEP(pA0,pA1,pB0,pB1,t+1,true,true,true);   WAIT_BAR(2); RESC(); ROT();
  }
  #undef CMASK
  #define CMASK(P0,P1,t) do{int jb_=(t)-(NT-4); if(jb_>=0)cmask(P0,P1,jb_,qrel,hi);}while(0)
  #define ENDW(tt) do{ if((tt)+3<NT){WAIT_BAR(2);} else if((tt)+2<NT){WAIT_BAR(1);} else {WAIT_BAR(0);} }while(0)
  for(;t+1<NT;t+=2){
    STEP(pB0,pB1,pA0,pA1,t,(t+3<NT),(t+1<NT),(t+1<NT));       ENDW(t);   RESC(); ROT();
    STEP(pA0,pA1,pB0,pB1,t+1,(t+4<NT),(t+2<NT),(t+2<NT));     ENDW(t+1); RESC(); ROT();
  }
  STEP(pB0,pB1,pA0,pA1,NT-1,false,false,false); RESC();
  { float sacc=pB0[0]+pB0[1]; _Pragma("unroll") for(int r=2;r<16;++r)sacc+=pB0[r]; _Pragma("unroll") for(int r=0;r<16;++r)sacc+=pB1[r]; l_reg+=sacc;
    pw0=(u32x4){PKW(pB0,0),PKW(pB0,2),PKW(pB0,4),PKW(pB0,6)};pw1=(u32x4){PKW(pB0,8),PKW(pB0,10),PKW(pB0,12),PKW(pB0,14)};pw2=(u32x4){PKW(pB1,0),PKW(pB1,2),PKW(pB1,4),PKW(pB1,6)};pw3=(u32x4){PKW(pB1,8),PKW(pB1,10),PKW(pB1,12),PKW(pB1,14)};
    SBAR(); pv(o,vb0+sl_cur,PAF(0),PAF(1),PAF(2),PAF(3)); }
  #undef PKW
  #undef PAF
  #undef VFR
  #undef PIN
  #undef MX3
  #undef GAPA
  #undef GAPB
  #undef EX
  #undef VRD
  #undef KRD
  #undef STEP
  #undef ENDW
  {auto rr=__builtin_amdgcn_permlane32_swap(__float_as_uint(l_reg),__float_as_uint(l_reg),false,false);l_reg=__uint_as_float(rr[0])+__uint_as_float(rr[1]);}
  if(hi==0)wsf[32+r32]=l_reg;asm volatile("s_waitcnt lgkmcnt(0)":::"memory");
  float rli[16];
  #pragma unroll
  for(int r=0;r<16;++r)rli[r]=__builtin_amdgcn_rcpf(wsf[32+crow(r,hi)]);
  bf16*Ow=O+(rowbase+q0+wid*QBLK)*OP+h*D;
  { bf16*stg=(bf16*)(shm+LDS_OST)+wid*2048;
    #pragma unroll
    for(int r=0;r<16;++r){const int orow=crow(r,hi);
      #pragma unroll
      for(int d0=0;d0<2;++d0)stg[orow*64+d0*32+r32]=__float2bfloat16(o[d0][r]*rli[r]);}
    asm volatile("s_waitcnt lgkmcnt(0)":::"memory");
    #pragma unroll
    for(int i=0;i<4;++i){const int row=i*8+(lane>>3),ch=lane&7; const u32x4 v=*(const u32x4*)(stg+row*64+ch*8); ATTN_STORE16(Ow+(long)row*OP+ch*8,v);} }
  asm volatile("s_waitcnt lgkmcnt(0)\n\ts_barrier":::"memory");
  #undef DMA_K
  #undef DMA_V
  #undef CMASK
  #undef START
  #undef RESC
  #undef ROT
}
constexpr int ATTN_LDS_BYTES=LDS_BYTES;
struct AttnTensors { const bf16* Q; const bf16* K; const bf16* V; bf16* O; };
struct AttnUnit { int bh; int qb; };
struct StaticOrder {
  int vcu,G;
  __device__ __forceinline__ explicit StaticOrder(int grid,int block):vcu((grid%8==0)?(block%8)*(grid/8)+block/8:block),G(grid){}
  __device__ __forceinline__ bool next(int i,AttnUnit&u)const{
    if(G==256){ if(i>=4)return false; const int s=vcu&1; u.bh=vcu>>1; u.qb=(i==0)?s:(i==1)?3-s:(i==2)?4+s:7-s; return true; }
    const int j=vcu+i*G; if(j>=BATCH*NHEAD*NQB)return false; u.bh=j/NQB; u.qb=j%NQB; return true; }
  __device__ __forceinline__ void a_ready(const AttnUnit&)const{}
  __device__ __forceinline__ void done(const AttnUnit&)const{}
};
template<class Sched,int THRL=8> __device__ __forceinline__ void attn_phase(char*lds,const AttnTensors&T,const Sched&S){
  AttnUnit u;
  for(int i=0;S.next(i,u);++i){ S.a_ready(u); attn_unit<THRL>(u.bh/NHEAD,u.bh%NHEAD,u.qb,T.Q,T.K,T.V,T.O,lds); S.done(u); }
}
#undef SBAR
#undef WAIT_BAR
}
namespace ret_body {
#define RB_LAS __attribute__((address_space(3)))
typedef short bf16x8 __attribute__((ext_vector_type(8)));
typedef short s16x4 __attribute__((ext_vector_type(4)));
typedef float f32x4 __attribute__((ext_vector_type(4)));
typedef unsigned u32x4 __attribute__((ext_vector_type(4)));
typedef unsigned u32x2 __attribute__((ext_vector_type(2)));
typedef unsigned short u16;
constexpr int QS = 528, VS = 144;
constexpr int L_Q = 0, L_K = 33792, L_ST = 67584, L_VT = 101376, L_VD = 110592, L_P = 119808, L_END = 129024;
__device__ __forceinline__ unsigned bfr(float f) { unsigned u = __builtin_bit_cast(unsigned, f); return (u + 0x7fffu + ((u >> 16) & 1u)) >> 16; }
__device__ __forceinline__ unsigned pk(float lo, float hi) { return bfr(lo) | (bfr(hi) << 16); }
__device__ __forceinline__ float lo16(unsigned u) { return __builtin_bit_cast(float, u << 16); }
__device__ __forceinline__ float hi16(unsigned u) { return __builtin_bit_cast(float, u & 0xffff0000u); }
#define RB_WAITL() asm volatile("s_waitcnt lgkmcnt(0)" ::: "memory")
#define RB_BAR() do { asm volatile("s_waitcnt lgkmcnt(0)" ::: "memory"); __builtin_amdgcn_s_barrier(); asm volatile("" ::: "memory"); } while (0)
#define RB_MFMA(a, b, c) __builtin_amdgcn_mfma_f32_16x16x32_bf16((a), (b), (c), 0, 0, 0)
__device__ __forceinline__ void ret_unit(RB_LAS unsigned char* lds, const u16* RQ, const u16* RK, u16* RVY, int b, int h, int sl) {
    int tid_ = threadIdx.x; asm volatile("" : "+v"(tid_));
    const int tid = tid_, lane = tid & 63, wid = __builtin_amdgcn_readfirstlane(tid >> 6), l15 = lane & 15, q4 = lane >> 4;
    const float g = log2f(1.0f - exp2f(-5.0f - (float)h));
    const size_t row0 = (size_t)b * 2048;
    const u16* qg = RQ + (row0 + (tid >> 5)) * 1024 + h * 256 + (tid & 31) * 8;
    const u16* kg = RK + (row0 + (tid >> 5)) * 1024 + h * 256 + (tid & 31) * 8;
    const u16* vg = RVY + (row0 + (tid >> 3)) * 2048 + h * 512 + sl * 64 + (tid & 7) * 8;
    const unsigned qoff = (unsigned)(tid >> 5) * QS + (unsigned)(tid & 31) * 16;
    for (int i = tid; i < 33792 / 16; i += 512) *(RB_LAS u32x4*)(lds + L_ST + 16 * i) = (u32x4){0u, 0u, 0u, 0u};
    f32x4 st[2][4];
#pragma unroll
    for (int a = 0; a < 2; ++a)
#pragma unroll
        for (int v = 0; v < 4; ++v) st[a][v] = (f32x4){0.f, 0.f, 0.f, 0.f};
    u32x4 qreg[4], kreg[4], vreg;
#pragma unroll
    for (int k = 0; k < 4; ++k) { qreg[k] = *(const u32x4*)(qg + (size_t)k * 16 * 1024); kreg[k] = *(const u32x4*)(kg + (size_t)k * 16 * 1024); }
    vreg = *(const u32x4*)vg;
    const int ib = wid >> 1, hb = 2 * (wid & 1);
    const float cd = exp2f(64.0f * g);
    const float qd = exp2f((float)(ib * 16 + l15 + 1) * g);
    const float vdec = exp2f((float)(63 - (tid >> 3)) * g);
    for (int c = 0; c < 32; ++c) {
#pragma unroll
        for (int k = 0; k < 4; ++k) { *(RB_LAS u32x4*)(lds + L_Q + qoff + k * 16 * QS) = qreg[k]; *(RB_LAS u32x4*)(lds + L_K + qoff + k * 16 * QS) = kreg[k]; }
        { const int j = tid >> 3, v8 = tid & 7;
#pragma unroll
          for (int e = 0; e < 4; ++e) { const unsigned w = vreg[e];
              RB_LAS u16* p0 = (RB_LAS u16*)(lds + L_VT + (8 * v8 + 2 * e) * VS + 2 * j); RB_LAS u16* p1 = (RB_LAS u16*)(lds + L_VT + (8 * v8 + 2 * e + 1) * VS + 2 * j);
              *p0 = (u16)(w & 0xffffu); *p1 = (u16)(w >> 16);
              RB_LAS u16* d0 = (RB_LAS u16*)(lds + L_VD + (8 * v8 + 2 * e) * VS + 2 * j); RB_LAS u16* d1 = (RB_LAS u16*)(lds + L_VD + (8 * v8 + 2 * e + 1) * VS + 2 * j);
              *d0 = (u16)bfr(lo16(w) * vdec); *d1 = (u16)bfr(hi16(w) * vdec); } }
        RB_BAR();
        if (c + 1 < 32) {
#pragma unroll
            for (int k = 0; k < 4; ++k) { qreg[k] = *(const u32x4*)(qg + (size_t)((c + 1) * 64 + k * 16) * 1024); kreg[k] = *(const u32x4*)(kg + (size_t)((c + 1) * 64 + k * 16) * 1024); }
            vreg = *(const u32x4*)(vg + (size_t)(c + 1) * 64 * 2048);
        }
        {
            f32x4 sacc[2]; sacc[0] = (f32x4){0.f, 0.f, 0.f, 0.f}; sacc[1] = sacc[0];
            if (hb <= ib) {
#pragma unroll
                for (int ks = 0; ks < 8; ++ks) {
                    const bf16x8 bq = *(const RB_LAS bf16x8*)(lds + L_Q + (ib * 16 + l15) * QS + ks * 64 + q4 * 16);
                    const bf16x8 a0 = *(const RB_LAS bf16x8*)(lds + L_K + (hb * 16 + l15) * QS + ks * 64 + q4 * 16);
                    sacc[0] = RB_MFMA(a0, bq, sacc[0]);
                    if (hb + 1 <= ib) { const bf16x8 a1 = *(const RB_LAS bf16x8*)(lds + L_K + ((hb + 1) * 16 + l15) * QS + ks * 64 + q4 * 16); sacc[1] = RB_MFMA(a1, bq, sacc[1]); }
                }
            }
            const int i = ib * 16 + l15;
#pragma unroll
            for (int tt = 0; tt < 2; ++tt) { const int jb = (hb + tt) * 16 + 4 * q4; float p[4];
#pragma unroll
                for (int r = 0; r < 4; ++r) { const int dlt = i - (jb + r); p[r] = (dlt >= 0) ? sacc[tt][r] * exp2f((float)dlt * g) : 0.f; }
                *(RB_LAS u32x2*)(lds + L_P + i * VS + jb * 2) = (u32x2){pk(p[0], p[1]), pk(p[2], p[3])}; }
        }
#pragma unroll
        for (int a = 0; a < 2; ++a)
#pragma unroll
            for (int v = 0; v < 4; ++v) st[a][v] = st[a][v] * cd;
#pragma unroll
        for (int ks = 0; ks < 2; ++ks) {
            bf16x8 bv[4];
#pragma unroll
            for (int v = 0; v < 4; ++v) bv[v] = *(const RB_LAS bf16x8*)(lds + L_VD + (v * 16 + l15) * VS + ks * 64 + q4 * 16);
#pragma unroll
            for (int db = 0; db < 2; ++db) { const int d0 = (2 * wid + db) * 16;
                RB_LAS unsigned char* ap = lds + L_K + (ks * 32 + 8 * q4 + (l15 >> 2)) * QS + (d0 + 4 * (lane & 3)) * 2;
                const s16x4 lo = __builtin_bit_cast(s16x4, __builtin_amdgcn_ds_read_tr16_b64_v4i16((RB_LAS s16x4*)ap));
                const s16x4 hi = __builtin_bit_cast(s16x4, __builtin_amdgcn_ds_read_tr16_b64_v4i16((RB_LAS s16x4*)(ap + 4 * QS)));
                const bf16x8 ka = (bf16x8){lo[0], lo[1], lo[2], lo[3], hi[0], hi[1], hi[2], hi[3]};
#pragma unroll
                for (int v = 0; v < 4; ++v) st[db][v] = RB_MFMA(ka, bv[v], st[db][v]); }
        }
        RB_BAR();
        {
            f32x4 oi[2], oc[2]; oi[0] = (f32x4){0.f, 0.f, 0.f, 0.f}; oi[1] = oi[0]; oc[0] = oi[0]; oc[1] = oi[0];
#pragma unroll
            for (int ks = 0; ks < 2; ++ks) { const bf16x8 bp = *(const RB_LAS bf16x8*)(lds + L_P + (ib * 16 + l15) * VS + ks * 64 + q4 * 16);
#pragma unroll
                for (int tt = 0; tt < 2; ++tt) { const bf16x8 av = *(const RB_LAS bf16x8*)(lds + L_VT + ((hb + tt) * 16 + l15) * VS + ks * 64 + q4 * 16); oi[tt] = RB_MFMA(av, bp, oi[tt]); } }
#pragma unroll
            for (int ks = 0; ks < 8; ++ks) { const bf16x8 bq = *(const RB_LAS bf16x8*)(lds + L_Q + (ib * 16 + l15) * QS + ks * 64 + q4 * 16);
#pragma unroll
                for (int tt = 0; tt < 2; ++tt) { const bf16x8 as = *(const RB_LAS bf16x8*)(lds + L_ST + ((hb + tt) * 16 + l15) * QS + ks * 64 + q4 * 16); oc[tt] = RB_MFMA(as, bq, oc[tt]); } }
            u16* yrow = RVY + (row0 + (size_t)c * 64 + ib * 16 + l15) * 2048 + h * 512 + sl * 64 + 4 * q4;
#pragma unroll
            for (int tt = 0; tt < 2; ++tt) { const f32x4 o = oi[tt] + oc[tt] * qd; *(u32x2*)(yrow + (hb + tt) * 16) = (u32x2){pk(o[0], o[1]), pk(o[2], o[3])}; }
        }
        RB_BAR();
#pragma unroll
        for (int db = 0; db < 2; ++db)
#pragma unroll
            for (int v = 0; v < 4; ++v) *(RB_LAS u32x2*)(lds + L_ST + (v * 16 + l15) * QS + ((2 * wid + db) * 16 + 4 * q4) * 2) = (u32x2){pk(st[db][v][0], st[db][v][1]), pk(st[db][v][2], st[db][v][3])};
    }
    RB_BAR();
}
#undef RB_MFMA
}
constexpr int NWAVES = 8;
constexpr int M = 16384, D = 1024, SEQ = 2048, DFF = 2816;
constexpr float LN_EPS = 1e-5f;
constexpr float ALPHA = 1.41421356237309515f;
constexpr float QSCALE = 0.125f * 1.4426950408889634f;
constexpr float LAMBDA_INIT = 0.2f;
constexpr size_t MiB = 1u << 20;
constexpr size_t WS_ECOS = 1 * MiB, WS_ESIN = 1 * MiB + 65536, WS_OCOS = 2 * MiB, WS_OSIN = 3 * MiB;
constexpr size_t WS_OWIN = 37 * MiB, WS_OWOUT = 49 * MiB, WS_EWIN = 86 * MiB, WS_EWOUT = 92 * MiB;
constexpr size_t WS_XB = 94 * MiB, WS_ACT = 126 * MiB;
constexpr size_t WS_H = WS_ACT;
constexpr size_t WS_EQ = WS_ACT, WS_EO = WS_ACT + 96 * MiB, WS_CAT = WS_ACT;
constexpr size_t WS_RQ = WS_ACT, WS_RK = WS_ACT + 32 * MiB, WS_RV = WS_ACT + 64 * MiB, WS_RG = WS_ACT + 128 * MiB;
constexpr size_t WS_YN = 53 * MiB;
constexpr size_t WS_END = 318 * MiB;
__host__ __device__ __forceinline__ size_t w1t_off(int idx) { return idx >= 2 ? (4 + (size_t)(idx - 2) * 11) * MiB : (53 + (size_t)idx * 11) * MiB; }
__host__ __device__ __forceinline__ size_t w2t_off(int idx) { return idx >= 2 ? 26 * MiB + (size_t)(idx - 2) * (MiB * 11 / 2) : 75 * MiB + (size_t)idx * (MiB * 11 / 2); }
constexpr int LDS_BYTES = 147456;

#define LAS __attribute__((address_space(3)))
typedef unsigned short bf16;
typedef unsigned v4u __attribute__((ext_vector_type(4)));
typedef unsigned v2u __attribute__((ext_vector_type(2)));
typedef float f32x4 __attribute__((ext_vector_type(4)));
#define LDS_WAIT() asm volatile("s_waitcnt lgkmcnt(0)" ::: "memory")
__device__ __forceinline__ unsigned f2bf(float f) { unsigned u = __builtin_bit_cast(unsigned, f); return (u + 0x7fffu + ((u >> 16) & 1u)) >> 16; }
__device__ __forceinline__ unsigned pk2(float lo, float hi) { return f2bf(lo) | (f2bf(hi) << 16); }
__device__ __forceinline__ float bflo(unsigned u) { return __builtin_bit_cast(float, u << 16); }
__device__ __forceinline__ float bfhi(unsigned u) { return __builtin_bit_cast(float, u & 0xffff0000u); }
__device__ __forceinline__ int opq(int v) { asm volatile("" : "+v"(v)); return v; }
__device__ __forceinline__ float wave_sum(float v) {
#pragma unroll
    for (int o = 1; o < 64; o <<= 1) v += __shfl_xor(v, o);
    return v;
}
__device__ __forceinline__ float wave_max(float v) {
#pragma unroll
    for (int o = 1; o < 64; o <<= 1) v = fmaxf(v, __shfl_xor(v, o));
    return v;
}

__device__ __forceinline__ int colmap(int mode, int n) {
    if (mode == 1) return (n >> 8) * 128 + (n & 127) + ((n >> 7) & 1) * DFF;
    if (mode == 2) { if (n < 1024) { const int p = n & 63; if (p < 16) { const int q = p >> 2; return n + (q == 1 ? 4 : (q == 2 ? -4 : 0)); } } return n; }
    return n;
}
__device__ __forceinline__ void p0_transpose_item(const float* W, int K, int N, bf16* WT, int mode, LAS float* scr, int item, int lane) {
    const int nblk = N / 32, kb = item / nblk, nb = item % nblk, k0 = 64 * kb, n0 = 32 * nb;
    const int sc = colmap(mode, n0 + (lane & 31));
#pragma unroll 8
    for (int i = 0; i < 32; ++i) { const int kk = 2 * i + (lane >> 5); scr[kk * 33 + (lane & 31)] = W[(size_t)(k0 + kk) * N + sc]; }
    LDS_WAIT(); asm volatile("" ::: "memory");
    const int c = lane & 7;
#pragma unroll
    for (int j = 0; j < 4; ++j) { const int n = (lane >> 3) + 8 * j; const LAS float* s = scr + (8 * c) * 33 + n;
        v4u o; o.x = pk2(s[0 * 33], s[1 * 33]); o.y = pk2(s[2 * 33], s[3 * 33]); o.z = pk2(s[4 * 33], s[5 * 33]); o.w = pk2(s[6 * 33], s[7 * 33]);
        *(v4u*)(WT + (size_t)(n0 + n) * K + k0 + 8 * c) = o; }
    LDS_WAIT(); asm volatile("" ::: "memory");
}

__device__ __forceinline__ void ln_row(const float* xrow, float* orow, bf16* brow, const float* g, const float* b, int lane) {
    const f32x4* xr = (const f32x4*)xrow + lane;
    f32x4 v[4]; float s = 0.f;
#pragma unroll
    for (int j = 0; j < 4; ++j) { v[j] = xr[64 * j]; s += (v[j].x + v[j].y) + (v[j].z + v[j].w); }
    const float mean = wave_sum(s) * (1.f / D); float s2 = 0.f;
#pragma unroll
    for (int j = 0; j < 4; ++j) { v[j] = v[j] - mean; s2 += (v[j].x * v[j].x + v[j].y * v[j].y) + (v[j].z * v[j].z + v[j].w * v[j].w); }
    const float rstd = 1.f / sqrtf(wave_sum(s2) * (1.f / D) + LN_EPS);
#pragma unroll
    for (int j = 0; j < 4; ++j) { const f32x4 gg = ((const f32x4*)g)[lane + 64 * j], bb = ((const f32x4*)b)[lane + 64 * j];
        const f32x4 y = v[j] * rstd * gg + bb;
        ((f32x4*)orow)[lane + 64 * j] = y;
        v2u o; o.x = pk2(y.x, y.y); o.y = pk2(y.z, y.w); ((v2u*)brow)[lane + 64 * j] = o; }
}

__device__ __forceinline__ void attn_naive(const bf16* Q, const bf16* K, const bf16* V, bf16* O, LAS float* sc, int gw, int NGW, int lane) {
    for (int item = gw; item < M * 8; item += NGW) {
        const int row = item >> 3, c = item & 7, b = row >> 11, t = row & 2047;
        const v4u* qp = (const v4u*)(Q + (size_t)row * 512 + c * 64);
        v4u q[8];
#pragma unroll
        for (int i = 0; i < 8; ++i) q[i] = qp[i];
        const bf16* Kb = K + (size_t)(b * SEQ) * 512 + c * 64;
        float mx = -INFINITY;
        for (int s0 = 0; s0 <= t; s0 += 64) { const int s = s0 + lane; float d = -INFINITY;
            if (s <= t) { const v4u* kp = (const v4u*)(Kb + (size_t)s * 512); float a = 0.f;
#pragma unroll
                for (int i = 0; i < 8; ++i) { const v4u kk = kp[i];
#pragma unroll
                    for (int w = 0; w < 4; ++w) a += bflo(q[i][w]) * bflo(kk[w]) + bfhi(q[i][w]) * bfhi(kk[w]); }
                d = a; }
            sc[s] = d; mx = fmaxf(mx, d); }
        mx = wave_max(mx);
        LDS_WAIT();
        float sum = 0.f;
        for (int s0 = 0; s0 <= t; s0 += 64) { const int s = s0 + lane; const float p = (s <= t) ? __builtin_amdgcn_exp2f(sc[s] - mx) : 0.f; sc[s] = p; sum += p; }
        sum = wave_sum(sum); const float inv = 1.0f / sum;
        LDS_WAIT();
        const bf16* Vb = V + (size_t)(b * SEQ) * 512 + (c >> 1) * 128 + 2 * lane;
        float o0 = 0.f, o1 = 0.f;
#pragma unroll 8
        for (int s = 0; s <= t; ++s) { const float p = sc[s]; const unsigned vv = *(const unsigned*)(Vb + (size_t)s * 512); o0 += p * bflo(vv); o1 += p * bfhi(vv); }
        *(unsigned*)(O + (size_t)row * 1024 + c * 128 + 2 * lane) = pk2(o0 * inv, o1 * inv);
        LDS_WAIT();
    }
}
__device__ __forceinline__ void post_attn(const bf16* O, const bf16* CB, const bf16* CC, const bf16* CX, bf16* CAT, const float* lamv, const float* ng, const float* cw, int gw, int NGW, int lane) {
    float l01 = lamv[lane] * lamv[64 + lane], l23 = lamv[128 + lane] * lamv[192 + lane];
    l01 = wave_sum(l01); l23 = wave_sum(l23);
    const float lam = expf(l01) - expf(l23) + LAMBDA_INIT;
    const float g0 = ng[2 * lane] * (1.0f - LAMBDA_INIT), g1 = ng[2 * lane + 1] * (1.0f - LAMBDA_INIT);
    f32x4 w0a = *(const f32x4*)(cw + 8 * lane), w0b = *(const f32x4*)(cw + 8 * lane + 4);
    f32x4 w1a = *(const f32x4*)(cw + 512 + 8 * lane), w1b = *(const f32x4*)(cw + 512 + 8 * lane + 4);
    f32x4 w2a = *(const f32x4*)(cw + 1024 + 8 * lane), w2b = *(const f32x4*)(cw + 1024 + 8 * lane + 4);
    for (int row = gw; row < M; row += NGW) {
        const int t = row & 2047;
        unsigned outw[4];
#pragma unroll
        for (int h = 0; h < 4; ++h) { const unsigned a = *(const unsigned*)(O + (size_t)row * 1024 + (2 * h) * 128 + 2 * lane), bq = *(const unsigned*)(O + (size_t)row * 1024 + (2 * h + 1) * 128 + 2 * lane);
            const float o0 = bflo(a) - lam * bflo(bq), o1 = bfhi(a) - lam * bfhi(bq);
            const float ss = wave_sum(o0 * o0 + o1 * o1);
            const float r = 1.0f / sqrtf(ss * (1.0f / 128.0f) + LN_EPS);
            outw[h] = pk2(o0 * r * g0, o1 * r * g1); }
        f32x4 ya = (f32x4){0.f, 0.f, 0.f, 0.f}, yb = ya;
#pragma unroll
        for (int k = 0; k < 3; ++k) { const int dt = 2 - k;
            if (t - dt >= 0) { const size_t off = (size_t)(row - dt) * 512 + 8 * lane; const v4u c = *(const v4u*)(CC + off), x = *(const v4u*)(CX + off);
                const f32x4 ua = (f32x4){bflo(c.x) * bflo(x.x), bfhi(c.x) * bfhi(x.x), bflo(c.y) * bflo(x.y), bfhi(c.y) * bfhi(x.y)};
                const f32x4 ub = (f32x4){bflo(c.z) * bflo(x.z), bfhi(c.z) * bfhi(x.z), bflo(c.w) * bflo(x.w), bfhi(c.w) * bfhi(x.w)};
                const f32x4 wa = k == 0 ? w0a : (k == 1 ? w1a : w2a), wb = k == 0 ? w0b : (k == 1 ? w1b : w2b);
                ya += wa * ua; yb += wb * ub; } }
        const v4u cb = *(const v4u*)(CB + (size_t)row * 512 + 8 * lane);
        v4u o; o.x = pk2(bflo(cb.x) * ya.x, bfhi(cb.x) * ya.y); o.y = pk2(bflo(cb.y) * ya.z, bfhi(cb.y) * ya.w); o.z = pk2(bflo(cb.z) * yb.x, bfhi(cb.z) * yb.y); o.w = pk2(bflo(cb.w) * yb.z, bfhi(cb.w) * yb.w);
        bf16* crow = CAT + (size_t)row * 1024;
#pragma unroll
        for (int h = 0; h < 4; ++h) *(unsigned*)(crow + h * 128 + 2 * lane) = outw[h];
        *(v4u*)(crow + 512 + 8 * lane) = o;
    }
}
__device__ __forceinline__ void ret_naive(const bf16* RQ, const bf16* RK, const bf16* RV, bf16* Y, LAS float* qs, LAS float* sc, int gw, int NGW, int lane) {
    for (int item = gw; item < M * 4; item += NGW) {
        const int row = item >> 2, h = item & 3, b = row >> 11, t = row & 2047;
        { const v2u qq = *(const v2u*)(RQ + (size_t)row * 1024 + h * 256 + 4 * lane);
          *(LAS f32x4*)(qs + 4 * lane) = (f32x4){bflo(qq.x), bfhi(qq.x), bflo(qq.y), bfhi(qq.y)}; }
        LDS_WAIT();
        const float l2g = log2f(1.0f - exp2f(-5.0f - (float)h));
        const bf16* Kb = RK + (size_t)(b * SEQ) * 1024 + h * 256;
        for (int s0 = 0; s0 <= t; s0 += 64) { const int s = s0 + lane; float a = 0.f;
            if (s <= t) { const v4u* kp = (const v4u*)(Kb + (size_t)s * 1024);
#pragma unroll 8
                for (int i = 0; i < 32; ++i) { const v4u kk = kp[i]; const f32x4 qa = *(const LAS f32x4*)(qs + 8 * i), qb = *(const LAS f32x4*)(qs + 8 * i + 4);
                    a += bflo(kk.x) * qa.x + bfhi(kk.x) * qa.y + bflo(kk.y) * qa.z + bfhi(kk.y) * qa.w + bflo(kk.z) * qb.x + bfhi(kk.z) * qb.y + bflo(kk.w) * qb.z + bfhi(kk.w) * qb.w; }
                a *= exp2f((float)(t - s) * l2g); }
            sc[s] = a; }
        LDS_WAIT();
        const bf16* Vb = RV + (size_t)(b * SEQ) * 2048 + h * 512 + 8 * lane;
        f32x4 ya = (f32x4){0.f, 0.f, 0.f, 0.f}, yb = ya;
#pragma unroll 4
        for (int s = 0; s <= t; ++s) { const float p = sc[s]; const v4u vv = *(const v4u*)(Vb + (size_t)s * 2048);
            ya += (f32x4){bflo(vv.x), bfhi(vv.x), bflo(vv.y), bfhi(vv.y)} * p; yb += (f32x4){bflo(vv.z), bfhi(vv.z), bflo(vv.w), bfhi(vv.w)} * p; }
        v4u o; o.x = pk2(ya.x, ya.y); o.y = pk2(ya.z, ya.w); o.z = pk2(yb.x, yb.y); o.w = pk2(yb.z, yb.w);
        *(v4u*)(Y + (size_t)row * 2048 + h * 512 + 8 * lane) = o;
        LDS_WAIT();
    }
}
__device__ __forceinline__ void post_ret(const bf16* Y, const bf16* RG, bf16* Z, const float* ng, int gw, int NGW, int lane) {
    for (int item = gw; item < M * 4; item += NGW) {
        const int row = item >> 2, h = item & 3; const size_t off = (size_t)row * 2048 + h * 512 + 8 * lane;
        const v4u yy = *(const v4u*)(Y + off), gg = *(const v4u*)(RG + off);
        f32x4 ya = (f32x4){bflo(yy.x), bfhi(yy.x), bflo(yy.y), bfhi(yy.y)}, yb = (f32x4){bflo(yy.z), bfhi(yy.z), bflo(yy.w), bfhi(yy.w)};
        const float mean = wave_sum((ya.x + ya.y) + (ya.z + ya.w) + (yb.x + yb.y) + (yb.z + yb.w)) * (1.0f / 512.0f);
        ya = ya - mean; yb = yb - mean;
        const float var = wave_sum((ya.x * ya.x + ya.y * ya.y) + (ya.z * ya.z + ya.w * ya.w) + (yb.x * yb.x + yb.y * yb.y) + (yb.z * yb.z + yb.w * yb.w)) * (1.0f / 512.0f);
        const float rstd = 1.0f / sqrtf(var + LN_EPS);
        const f32x4 na = *(const f32x4*)(ng + h * 512 + 8 * lane), nb = *(const f32x4*)(ng + h * 512 + 8 * lane + 4);
        const f32x4 ga = (f32x4){bflo(gg.x), bfhi(gg.x), bflo(gg.y), bfhi(gg.y)}, gb = (f32x4){bflo(gg.z), bfhi(gg.z), bflo(gg.w), bfhi(gg.w)};
        ya = ya * rstd * na * ga; yb = yb * rstd * nb * gb;
        v4u o; o.x = pk2(ya.x, ya.y); o.y = pk2(ya.z, ya.w); o.z = pk2(yb.x, yb.y); o.w = pk2(yb.z, yb.w);
        *(v4u*)(Z + off) = o;
    }
}
#ifndef MK_MULTI
#define MK_MULTI 0
#endif
#ifndef NAIVE_ATTN
#define NAIVE_ATTN 0
#endif
#ifndef NAIVE_RET
#define NAIVE_RET 0
#endif
constexpr int N_PHASES = 23;
struct Args { const float* in[13]; float* out; unsigned char* ws; int ph_lo, ph_hi; };
template <bool COOP>
__global__ void __launch_bounds__(NWAVES * 64, 2) mk_fwd(Args args) {
    extern __shared__ __attribute__((aligned(16))) unsigned char lds[];
    LAS unsigned char* ldsp = (LAS unsigned char*)lds;
    const int tid = threadIdx.x, lane = tid & 63, wave = __builtin_amdgcn_readfirstlane(tid >> 6);
    const int G = gridDim.x, bx = blockIdx.x;
    const int gw = bx * NWAVES + wave, NGW = G * NWAVES;
    unsigned char* ws = args.ws;
    float* out = args.out;
    bf16* XB = (bf16*)(ws + WS_XB);
    const int lo = args.ph_lo, hi = args.ph_hi;
#define IN(k) (lo <= (k) && (k) < hi)
#define GRID_SYNC() do { if (COOP) { cg::this_grid().sync(); } } while (0)

    if (IN(0)) {
        LAS float* scr = (LAS float*)(ldsp + wave * 16384);
        constexpr int I_1 = (D / 64) * (2 * DFF / 32), I_2 = (DFF / 64) * (D / 32), I_EI = (D / 64) * (3072 / 32), I_EO = (D / 64) * (D / 32), I_OI = (D / 64) * (6144 / 32), I_OO = (2048 / 64) * (D / 32);
        constexpr int NITEMS = 4 * I_1 + 4 * I_2 + I_EI + I_EO + I_OI + I_OO;
        for (int it = gw; it < NITEMS; it += NGW) {
            int r = it;
            if (r < 4 * I_1) { const int idx = r / I_1; p0_transpose_item(args.in[3] + (size_t)idx * D * 2 * DFF, D, 2 * DFF, (bf16*)(ws + w1t_off(idx)), 1, scr, r % I_1, lane); continue; } r -= 4 * I_1;
            if (r < 4 * I_2) { const int idx = r / I_2; p0_transpose_item(args.in[4] + (size_t)idx * DFF * D, DFF, D, (bf16*)(ws + w2t_off(idx)), 0, scr, r % I_2, lane); continue; } r -= 4 * I_2;
            if (r < I_EI) { p0_transpose_item(args.in[5], D, 3072, (bf16*)(ws + WS_EWIN), 2, scr, r, lane); continue; } r -= I_EI;
            if (r < I_EO) { p0_transpose_item(args.in[6], D, D, (bf16*)(ws + WS_EWOUT), 0, scr, r, lane); continue; } r -= I_EO;
            if (r < I_OI) { p0_transpose_item(args.in[10], D, 6144, (bf16*)(ws + WS_OWIN), 0, scr, r, lane); continue; } r -= I_OI;
            p0_transpose_item(args.in[11], 2048, D, (bf16*)(ws + WS_OWOUT), 0, scr, r, lane);
        }
        for (int m = gw; m < M; m += NGW) {
            const f32x4* xr = (const f32x4*)(args.in[0] + (size_t)m * D) + lane;
#pragma unroll
            for (int j = 0; j < 4; ++j) { const f32x4 v = xr[64 * j]; v2u o; o.x = pk2(v.x, v.y); o.y = pk2(v.z, v.w); ((v2u*)(XB + (size_t)m * D))[lane + 64 * j] = o; }
        }
        { float* ecos = (float*)(ws + WS_ECOS); float* esin = (float*)(ws + WS_ESIN); float* ocos = (float*)(ws + WS_OCOS); float* osin = (float*)(ws + WS_OSIN);
          const int gt = bx * (NWAVES * 64) + tid, NGT = G * NWAVES * 64;
          for (int e = gt; e < SEQ * 8; e += NGT) { const int pos = e >> 3, i = e & 7; const float inv = expf((-13.122363377404328f * (float)i) * 0.125f); const float ang = (float)pos * inv; ecos[e] = cosf(ang); esin[e] = sinf(ang); }
          for (int e = gt; e < SEQ * 128; e += NGT) { const int pos = e >> 7, i = e & 127; const float inv = expf((-9.210340371976184f * (float)i) * 0.0078125f); const float ang = (float)pos * inv; ocos[e] = cosf(ang); osin[e] = sinf(ang); } }
        GRID_SYNC();
    }
    for (int layer = 0; layer < 2; ++layer) {
        const int pb = 1 + 11 * layer;
        const float* lng = args.in[1] + (size_t)layer * 3 * D; const float* lnb = args.in[2] + (size_t)layer * 3 * D;
#define FFN_STEP(slot, ph0, lnk) do { \
        const int idx_ = layer * 2 + (slot); \
        if (IN(pb + (ph0))) { pg8::Gemm g{XB, (const bf16*)(ws + w1t_off(idx_)), M, 2 * DFF, D}; pg8::StaticOrder S; S.init(M, 2 * DFF, G, bx); \
            pg8::EpiSwiglu E{(bf16*)(ws + WS_H), DFF}; pg8::gemm_phase<pg8::EpiSwiglu, pg8::StaticOrder, true, true>(ldsp, g, S, E); GRID_SYNC(); } \
        if (IN(pb + (ph0) + 1)) { pg8::Gemm g{(const bf16*)(ws + WS_H), (const bf16*)(ws + w2t_off(idx_)), M, D, DFF}; pg8::StaticOrder S; S.init(M, D, G, bx); \
            pg8::EpiResid E{(layer == 0 && (slot) == 0) ? args.in[0] : out, out, ALPHA, 0.5f}; pg8::gemm_phase<pg8::EpiResid, pg8::StaticOrder, true, true>(ldsp, g, S, E); GRID_SYNC(); } \
        if (IN(pb + (ph0) + 2)) { for (int m = gw; m < M; m += NGW) ln_row(out + (size_t)m * D, out + (size_t)m * D, XB + (size_t)m * D, lng + (lnk) * D, lnb + (lnk) * D, opq(lane)); GRID_SYNC(); } \
    } while (0)
        FFN_STEP(0, 0, 0);
        if (layer == 0) {
            bf16* EQ = (bf16*)(ws + WS_EQ);
            if (IN(pb + 3)) { pg8::Gemm g{XB, (const bf16*)(ws + WS_EWIN), M, 3072, D}; pg8::StaticOrder S; S.init(M, 3072, G, bx);
                pg8::EpiEvenIn E{EQ, (size_t)M * 512, (const float*)(ws + WS_ECOS), (const float*)(ws + WS_ESIN), QSCALE};
                pg8::gemm_phase<pg8::EpiEvenIn, pg8::StaticOrder, true, true>(ldsp, g, S, E); GRID_SYNC(); }
            if (IN(pb + 4)) {
#if NAIVE_ATTN
                attn_naive(EQ, EQ + (size_t)M * 512, EQ + (size_t)2 * M * 512, (bf16*)(ws + WS_EO), (LAS float*)(ldsp + wave * 8192), gw, NGW, opq(lane));
#else
                const attn_body::AttnTensors AT{(const attn_body::bf16*)EQ, (const attn_body::bf16*)(EQ + (size_t)M * 512), (const attn_body::bf16*)(EQ + (size_t)2 * M * 512), (attn_body::bf16*)(ws + WS_EO)};
                const attn_body::StaticOrder S(G, bx);
                attn_body::attn_phase<attn_body::StaticOrder>((char*)lds, AT, S);
#endif
                GRID_SYNC(); }
            if (IN(pb + 5)) { post_attn((const bf16*)(ws + WS_EO), EQ + (size_t)3 * M * 512, EQ + (size_t)4 * M * 512, EQ + (size_t)5 * M * 512, (bf16*)(ws + WS_CAT), args.in[7], args.in[8], args.in[9], gw, NGW, opq(lane)); GRID_SYNC(); }
            if (IN(pb + 6)) { pg8::Gemm g{(const bf16*)(ws + WS_CAT), (const bf16*)(ws + WS_EWOUT), M, D, D}; pg8::StaticOrder S; S.init(M, D, G, bx);
                pg8::EpiResid E{out, out, ALPHA, 1.0f}; pg8::gemm_phase<pg8::EpiResid, pg8::StaticOrder, true, true>(ldsp, g, S, E); GRID_SYNC(); }
        } else {
            bf16* RQ = (bf16*)(ws + WS_RQ); bf16* RK = (bf16*)(ws + WS_RK); bf16* RV = (bf16*)(ws + WS_RV); bf16* RG = (bf16*)(ws + WS_RG);
#if NAIVE_RET
            bf16* Y = (bf16*)(ws + WS_YN);
#else
            bf16* Y = RV;
#endif
            if (IN(pb + 3)) { pg8::Gemm g{XB, (const bf16*)(ws + WS_OWIN), M, 6144, D}; pg8::StaticOrder S; S.init(M, 6144, G, bx);
                pg8::EpiOddIn E{RQ, RK, RV, RG, (const float*)(ws + WS_OCOS), (const float*)(ws + WS_OSIN)};
                pg8::gemm_phase<pg8::EpiOddIn, pg8::StaticOrder, true, true>(ldsp, g, S, E); GRID_SYNC(); }
            if (IN(pb + 4)) {
#if NAIVE_RET
                ret_naive(RQ, RK, RV, Y, (LAS float*)(ldsp + wave * 9216), (LAS float*)(ldsp + wave * 9216 + 1024), gw, NGW, opq(lane));
#else
                { const int vcu = (G % 8 == 0) ? (bx % 8) * (G / 8) + bx / 8 : bx;
                  for (int u = vcu; u < 256; u += G) ret_body::ret_unit(ldsp, RQ, RK, RV, u >> 5, (u >> 3) & 3, u & 7); }
#endif
                GRID_SYNC(); }
            if (IN(pb + 5)) { post_ret(Y, RG, Y, args.in[12], gw, NGW, opq(lane)); GRID_SYNC(); }
            if (IN(pb + 6)) { pg8::Gemm g{Y, (const bf16*)(ws + WS_OWOUT), M, D, 2048}; pg8::StaticOrder S; S.init(M, D, G, bx);
                pg8::EpiResid E{out, out, ALPHA, 1.0f}; pg8::gemm_phase<pg8::EpiResid, pg8::StaticOrder, true, true>(ldsp, g, S, E); GRID_SYNC(); }
        }
        if (IN(pb + 7)) { for (int m = gw; m < M; m += NGW) ln_row(out + (size_t)m * D, out + (size_t)m * D, XB + (size_t)m * D, lng + 1 * D, lnb + 1 * D, opq(lane)); GRID_SYNC(); }
        FFN_STEP(1, 8, 2);
    }
#undef IN
}

extern "C" void kernel_launch(void* const* d_in, const int* in_sizes, int n_in, void* d_out, int out_size, void* d_ws, size_t ws_size, hipStream_t stream) {
    static int grid = 0;
    if (grid == 0) {
        if (n_in != 13 || out_size != M * D || ws_size < WS_END) { fprintf(stderr, "kernel_launch: unexpected problem (n_in %d, out %d, ws %zu)\n", n_in, out_size, ws_size); grid = -1; return; }
        int dev = 0, cus = 0, per_cu = 0;
        hipGetDevice(&dev); hipDeviceGetAttribute(&cus, hipDeviceAttributeMultiprocessorCount, dev);
#if MK_MULTI
        const void* kf = (const void*)mk_fwd<false>;
#else
        const void* kf = (const void*)mk_fwd<true>;
#endif
        if (hipFuncSetAttribute(kf, hipFuncAttributeMaxDynamicSharedMemorySize, LDS_BYTES) != hipSuccess) { fprintf(stderr, "kernel_launch: hipFuncSetAttribute failed\n"); grid = -1; return; }
        if (hipOccupancyMaxActiveBlocksPerMultiprocessor(&per_cu, kf, NWAVES * 64, LDS_BYTES) != hipSuccess || per_cu < 1) { fprintf(stderr, "kernel_launch: occupancy query says %d\n", per_cu); per_cu = 1; }
        (void)hipGetLastError();
        grid = cus * per_cu;
    }
    if (grid < 0) return;
    Args a{};
    for (int i = 0; i < 13; ++i) a.in[i] = (const float*)d_in[i];
    a.out = (float*)d_out; a.ws = (unsigned char*)d_ws;
#if MK_MULTI
    for (int ph = 0; ph < N_PHASES; ++ph) { a.ph_lo = ph; a.ph_hi = ph + 1; hipLaunchKernelGGL(mk_fwd<false>, dim3(grid), dim3(NWAVES * 64), LDS_BYTES, stream, a); }
#else
    a.ph_lo = 0; a.ph_hi = N_PHASES;
    void* kargs[] = {&a};
    hipError_t e = hipLaunchCooperativeKernel((const void*)mk_fwd<true>, dim3(grid), dim3(NWAVES * 64), kargs, LDS_BYTES, stream);
    if (e != hipSuccess) fprintf(stderr, "cooperative launch failed: %s (grid %d)\n", hipGetErrorString(e), grid);
#endif
}
```
